# Optimizing an MI355X kernel written in HIP

```python
import jax, jax.numpy as jnp
from jax import lax
import numpy as np

D_MODEL = 2048
BATCH = 2
SEQ = 16384
DEPTH = 2

GRID_W = 64
CTX_LEN = 256
ROPE_BASE = 10000.0
NORM_EPS = 1e-6
NEG_INF = -1e30

RW_HEADS = 16
RW_HEAD_DIM = 64
RW_WIDTH = RW_HEADS * RW_HEAD_DIM
RW_DECAY_LORA = 96
RW_AAA_LORA = 96
RW_MV_LORA = 64
RW_GATE_LORA = 64
RW_LNX_EPS = 64e-5

WA_HEADS = 16
WA_KV_HEADS = 4
WA_GROUP = WA_HEADS // WA_KV_HEADS
WA_HEAD_DIM = 64
WA_WIDTH = WA_HEADS * WA_HEAD_DIM
WINDOW = 128
BLOCK = 128
WA_SCALE = WA_HEAD_DIM ** -0.5

MLA_HEADS = 8
MLA_NOPE = 128
MLA_ROPE = 64
MLA_V = 128
MLA_Q_LORA = 512
MLA_KV_LORA = 512
MLA_WIDTH = MLA_HEADS * MLA_V
MLA_SCALE = (MLA_NOPE + MLA_ROPE) ** -0.5

N_BRANCH = 3
BRANCH_WIDTH = 1024

D_FF = 5632
CONV_W = 3

RW_SPLITS = (RW_WIDTH, RW_WIDTH, RW_WIDTH, RW_DECAY_LORA, RW_DECAY_LORA, RW_AAA_LORA, RW_AAA_LORA, RW_GATE_LORA)
RW_COLS = 3 * RW_WIDTH + 2 * RW_DECAY_LORA + 2 * RW_AAA_LORA + RW_GATE_LORA
WA_COLS = WA_HEADS * WA_HEAD_DIM + 2 * WA_KV_HEADS * WA_HEAD_DIM
MLA_COLS = MLA_Q_LORA + MLA_KV_LORA + MLA_ROPE
GATE_COLS = N_BRANCH * D_MODEL
IN_SPLITS = (RW_COLS, WA_COLS, MLA_COLS, GATE_COLS)
IN_COLS = RW_COLS + WA_COLS + MLA_COLS + GATE_COLS

kernel_name = "hybrid_rwkv7_swa_mla_dit_block"


def split_last(z, sizes):
    out, off = [], 0
    for s in sizes:
        out.append(z[..., off:off + s])
        off += s
    return out


def rmsnorm(z, g):
    zf = z.astype(jnp.float32)
    zf = zf * lax.rsqrt(jnp.mean(zf * zf, axis=-1, keepdims=True) + NORM_EPS)
    return (zf * g.astype(jnp.float32)).astype(z.dtype)


def modulate(n, shift, scale):
    return n * (1 + scale) + shift


def axial_rope_table(rows, dim):
    nf = dim // 4
    inv = ROPE_BASE ** (-jnp.arange(nf, dtype=jnp.float32) / nf)
    row = jnp.repeat(jnp.arange(rows, dtype=jnp.float32), GRID_W)
    col = jnp.tile(jnp.arange(GRID_W, dtype=jnp.float32), rows)
    ang = jnp.concatenate([row[:, None] * inv, col[:, None] * inv], axis=-1)
    return jnp.cos(ang), jnp.sin(ang)


def apply_rope(z, cos, sin):
    half = z.shape[-1] // 2
    zf = z.astype(jnp.float32)
    z1, z2 = zf[..., :half], zf[..., half:]
    cs, sn = cos[None, :, None, :], sin[None, :, None, :]
    return jnp.concatenate([z1 * cs - z2 * sn, z1 * sn + z2 * cs], axis=-1).astype(z.dtype)


def token_lerp(z, mu):
    zp = jnp.pad(z, ((0, 0), (1, 1), (0, 0)))
    return z + mu * (0.5 * (zp[:, :-2] + zp[:, 2:]) - z)


def depthwise_conv(z, w, b):
    half = CONV_W // 2
    T = z.shape[1]
    zp = jnp.pad(z, ((0, 0), (half, half), (0, 0)))
    out = b
    for j in range(CONV_W):
        out = out + zp[:, j:j + T] * w[j]
    return out


def wkv7_scan(r, w, k, v, a, b):
    Bn, S, H, N = r.shape

    def step(state, xs):
        r_t, w_t, k_t, v_t, a_t, b_t = xs
        sa = jnp.einsum('bhvk,bhk->bhv', state, a_t)
        state = state * w_t[:, :, None, :] + sa[..., None] * b_t[:, :, None, :] + v_t[..., None] * k_t[:, :, None, :]
        return state, jnp.einsum('bhvk,bhk->bhv', state, r_t)

    xs = tuple(jnp.moveaxis(t.astype(jnp.float32), 1, 0) for t in (r, w, k, v, a, b))
    _, y = lax.scan(step, jnp.zeros((Bn, H, N, N), jnp.float32), xs)
    return jnp.moveaxis(y, 0, 1)


def rwkv7_branch(zc, zl, v_first, vres, mu, w0, w2, a0, a2, g2, k_k, k_a, r_k, lnx_g, lnx_b):
    L = zc.shape[1]
    z = jnp.concatenate([token_lerp(zc, mu), token_lerp(zl, mu)], axis=1)
    Bn, S = z.shape[:2]
    r, k, v, wdf, wdb, adf, adb, gd = split_last(z, RW_SPLITS)
    if vres is None:
        v_first = v
    else:
        v0, v1, v2 = vres
        v = v + (v_first - v) * jax.nn.sigmoid(v0 + (v @ v1) @ v2)
    g = jax.nn.sigmoid(gd) @ g2

    def heads(t):
        return t.reshape(Bn, S, RW_HEADS, RW_HEAD_DIM)

    kk = heads((k * k_k).astype(jnp.float32))
    kk = kk / jnp.maximum(jnp.linalg.norm(kk, axis=-1, keepdims=True), 1e-12)
    rh, vh = heads(r), heads(v)

    def fwd(t):
        return t

    def bwd(t):
        return jnp.concatenate([t[:, :L][:, ::-1], t[:, L:][:, ::-1]], axis=1)

    def direction(wd, ad, d, order):
        wlog = -jax.nn.softplus(-(w0[d] + jnp.tanh(wd) @ w2[d]).astype(jnp.float32)) - 0.5
        decay = jnp.exp(-jnp.exp(wlog))
        a = jax.nn.sigmoid((a0[d] + ad @ a2[d]).astype(jnp.float32))
        kd = heads(k * (1 + (a - 1) * k_a))
        ys = wkv7_scan(order(rh), order(heads(decay)), order(kd), order(vh), order(-kk), order(kk * heads(a)))
        return order(ys), kd

    y_f, k_f = direction(wdf, adf, 0, fwd)
    y_b, k_b = direction(wdb, adb, 1, bwd)
    y = y_f + y_b
    mean = jnp.mean(y, axis=-1, keepdims=True)
    var = jnp.mean(jnp.square(y - mean), axis=-1, keepdims=True)
    y = ((y - mean) * lax.rsqrt(var + RW_LNX_EPS)).reshape(Bn, S, RW_WIDTH) * lnx_g + lnx_b
    bonus = (jnp.sum(rh * (k_f + k_b) * r_k, axis=-1, keepdims=True) * vh).reshape(Bn, S, RW_WIDTH)
    out = ((y + bonus) * g).astype(zl.dtype)
    return out[:, :L], out[:, L:], v_first


def window_sink_attention(q, k, v, kc, vc, sink):
    Bn, T = q.shape[:2]
    Lc = kc.shape[1]
    nb = T // BLOCK
    span = BLOCK + 2 * WINDOW
    kp = jnp.pad(k, ((0, 0), (WINDOW, WINDOW), (0, 0), (0, 0)))
    vp = jnp.pad(v, ((0, 0), (WINDOW, WINDOW), (0, 0), (0, 0)))
    qb = jnp.moveaxis(q.reshape(Bn, nb, BLOCK, WA_KV_HEADS, WA_GROUP, WA_HEAD_DIM), 1, 0)
    rel = jnp.arange(span)[None, :] - WINDOW - jnp.arange(BLOCK)[:, None]
    sink_f = sink.astype(jnp.float32)[None, :, :, None, None]

    def one_block(args):
        i, qi = args
        start = i * BLOCK
        ki = lax.dynamic_slice_in_dim(kp, start, span, axis=1)
        vi = lax.dynamic_slice_in_dim(vp, start, span, axis=1)
        kpos = start - WINDOW + jnp.arange(span)
        valid = (jnp.abs(rel) <= WINDOW) & ((kpos >= 0) & (kpos < T))[None, :]
        s_loc = jnp.einsum('bqhgd,bkhd->bhgqk', qi, ki).astype(jnp.float32) * WA_SCALE
        s_loc = jnp.where(valid, s_loc, NEG_INF)
        s_ctx = jnp.einsum('bqhgd,blhd->bhgql', qi, kc).astype(jnp.float32) * WA_SCALE
        s_sink = jnp.broadcast_to(sink_f, s_loc.shape[:-1] + (1,))
        p = jax.nn.softmax(jnp.concatenate([s_loc, s_ctx, s_sink], axis=-1), axis=-1).astype(v.dtype)
        return (jnp.einsum('bhgqk,bkhd->bqhgd', p[..., :span], vi)
                + jnp.einsum('bhgql,blhd->bqhgd', p[..., span:span + Lc], vc))

    o = lax.map(one_block, (jnp.arange(nb), qb))
    return jnp.moveaxis(o, 0, 1).reshape(Bn, T, WA_WIDTH)


def context_sink_attention(q, k, v, sink):
    s = jnp.einsum('bqhgd,blhd->bhgql', q, k).astype(jnp.float32) * WA_SCALE
    s_sink = jnp.broadcast_to(sink.astype(jnp.float32)[None, :, :, None, None], s.shape[:-1] + (1,))
    p = jax.nn.softmax(jnp.concatenate([s, s_sink], axis=-1), axis=-1)[..., :-1].astype(v.dtype)
    o = jnp.einsum('bhgql,blhd->bqhgd', p, v)
    return o.reshape(q.shape[0], q.shape[1], WA_WIDTH)


def windowed_gqa_branch(zc, zl, sink, cos, sin, need_ctx):
    sink = sink.reshape(WA_KV_HEADS, WA_GROUP)

    def heads(z, rope):
        Bn, T = z.shape[:2]
        q, k, v = split_last(z, (WA_HEADS * WA_HEAD_DIM, WA_KV_HEADS * WA_HEAD_DIM, WA_KV_HEADS * WA_HEAD_DIM))
        q = q.reshape(Bn, T, WA_HEADS, WA_HEAD_DIM)
        k = k.reshape(Bn, T, WA_KV_HEADS, WA_HEAD_DIM)
        v = v.reshape(Bn, T, WA_KV_HEADS, WA_HEAD_DIM)
        if rope:
            q, k = apply_rope(q, cos, sin), apply_rope(k, cos, sin)
        return q.reshape(Bn, T, WA_KV_HEADS, WA_GROUP, WA_HEAD_DIM), k, v

    qc, kc, vc = heads(zc, False)
    ql, kl, vl = heads(zl, True)
    out_l = window_sink_attention(ql, kl, vl, kc, vc, sink)
    out_c = context_sink_attention(qc, kc, vc, sink) if need_ctx else None
    return out_c, out_l


def dense_attention(q, k, v, scale):
    Bn, T, H, dq = q.shape
    nb = T // BLOCK
    qb = jnp.moveaxis(q.reshape(Bn, nb, BLOCK, H, dq), 1, 0)

    def one_block(qi):
        s = jnp.einsum('bqhd,bshd->bhqs', qi, k).astype(jnp.float32) * scale
        p = jax.nn.softmax(s, axis=-1).astype(v.dtype)
        return jnp.einsum('bhqs,bshd->bqhd', p, v)

    o = lax.map(one_block, qb)
    return jnp.moveaxis(o, 0, 1).reshape(Bn, T, H * v.shape[-1])


def mla_branch(zc, zl, qnorm_g, kvnorm_g, w_uq, w_ukv, cos, sin, need_ctx):
    def project(z, rope):
        Bn, T = z.shape[:2]
        cq, ckv, kr = split_last(z, (MLA_Q_LORA, MLA_KV_LORA, MLA_ROPE))
        q = (rmsnorm(cq, qnorm_g) @ w_uq).reshape(Bn, T, MLA_HEADS, MLA_NOPE + MLA_ROPE)
        kv = (rmsnorm(ckv, kvnorm_g) @ w_ukv).reshape(Bn, T, MLA_HEADS, MLA_NOPE + MLA_V)
        q_nope, q_rope = q[..., :MLA_NOPE], q[..., MLA_NOPE:]
        k_nope, v = kv[..., :MLA_NOPE], kv[..., MLA_NOPE:]
        kr = kr[:, :, None, :]
        if rope:
            q_rope, kr = apply_rope(q_rope, cos, sin), apply_rope(kr, cos, sin)
        q = jnp.concatenate([q_nope, q_rope], axis=-1)
        k = jnp.concatenate([k_nope, jnp.broadcast_to(kr, k_nope.shape[:-1] + (MLA_ROPE,))], axis=-1)
        return q, k, v

    qc, kc, vc = project(zc, False)
    ql, kl, vl = project(zl, True)
    out_l = dense_attention(ql, jnp.concatenate([kc, kl], axis=1), jnp.concatenate([vc, vl], axis=1), MLA_SCALE)
    out_c = dense_attention(qc, kc, vc, MLA_SCALE) if need_ctx else None
    return out_c, out_l


def merge_branches(gate_cols, outs, w_branch_l, w_out_l):
    gates = jax.nn.sigmoid(gate_cols)
    y = gates[..., :D_MODEL] * (outs[0] @ w_branch_l[0])
    for i in range(1, N_BRANCH):
        y = y + gates[..., i * D_MODEL:(i + 1) * D_MODEL] * (outs[i] @ w_branch_l[i])
    return y @ w_out_l


def conv_glu(h, w_in, conv_w, conv_b, w_out):
    gt, u = jnp.split(h @ w_in, 2, axis=-1)
    return (jax.nn.gelu(depthwise_conv(gt, conv_w, conv_b), approximate=True) * u) @ w_out


def setup_inputs(seed: int = 0) -> dict:
    key = jax.random.key(seed)
    ks = iter(jax.random.split(key, 48))

    def nrm(shape, s):
        return jax.random.normal(next(ks), shape, jnp.float32) * s

    def unif(shape, lo, hi):
        return jax.random.uniform(next(ks), shape, jnp.float32, lo, hi)

    L, D = DEPTH, D_MODEL
    return {
        "x": nrm((BATCH, SEQ, D), 1.0),
        "c": nrm((BATCH, D), 1.0),
        "ctx": nrm((BATCH, CTX_LEN, D), 1.0),
        "c_ctx": nrm((D,), 1.0),
        "ada_w": nrm((L, D, 6 * D), 0.5 * D ** -0.5),
        "ada_b": nrm((L, 6 * D), 0.02),
        "norm1_g": 1.0 + nrm((L, D), 0.05),
        "w_in": nrm((L, D, IN_COLS), D ** -0.5),
        "rw_mu": unif((L, RW_COLS), 0.0, 1.0),
        "rw_w0": unif((L, 2, RW_WIDTH), -6.5, -1.5),
        "rw_w2": nrm((L, 2, RW_DECAY_LORA, RW_WIDTH), 0.5 * RW_DECAY_LORA ** -0.5),
        "rw_a0": nrm((L, 2, RW_WIDTH), 0.1),
        "rw_a2": nrm((L, 2, RW_AAA_LORA, RW_WIDTH), 0.5 * RW_AAA_LORA ** -0.5),
        "rw_g2": nrm((L, RW_GATE_LORA, RW_WIDTH), RW_GATE_LORA ** -0.5),
        "rw_kk": 0.85 + nrm((L, RW_WIDTH), 0.05),
        "rw_ka": 1.0 + nrm((L, RW_WIDTH), 0.05),
        "rw_rk": nrm((L, RW_HEADS, RW_HEAD_DIM), 0.1),
        "rw_lnx_g": 1.0 + nrm((L, RW_WIDTH), 0.05),
        "rw_lnx_b": nrm((L, RW_WIDTH), 0.01),
        "rw_v0": 1.0 + nrm((L - 1, RW_WIDTH), 0.1),
        "rw_v1": nrm((L - 1, RW_WIDTH, RW_MV_LORA), RW_WIDTH ** -0.5),
        "rw_v2": nrm((L - 1, RW_MV_LORA, RW_WIDTH), 0.5 * RW_MV_LORA ** -0.5),
        "wa_sink": nrm((L, WA_HEADS), 0.5),
        "mla_qnorm_g": 1.0 + nrm((L, MLA_Q_LORA), 0.05),
        "mla_kvnorm_g": 1.0 + nrm((L, MLA_KV_LORA), 0.05),
        "mla_w_uq": nrm((L, MLA_Q_LORA, MLA_HEADS * (MLA_NOPE + MLA_ROPE)), MLA_Q_LORA ** -0.5),
        "mla_w_ukv": nrm((L, MLA_KV_LORA, MLA_HEADS * (MLA_NOPE + MLA_V)), MLA_KV_LORA ** -0.5),
        "w_branch": nrm((L, N_BRANCH, BRANCH_WIDTH, D), BRANCH_WIDTH ** -0.5),
        "w_out": nrm((L, D, D), D ** -0.5),
        "norm2_g": 1.0 + nrm((L, D), 0.05),
        "ffn_w_in": nrm((L, D, 2 * D_FF), D ** -0.5),
        "ffn_conv_w": nrm((L, CONV_W, D_FF), 0.5),
        "ffn_conv_b": nrm((L, D_FF), 0.02),
        "ffn_w_out": nrm((L, D_FF, D), D_FF ** -0.5),
        "final_norm_g": 1.0 + nrm((D,), 0.05),
    }


def reference(x, c, ctx, c_ctx, ada_w, ada_b, norm1_g, w_in, rw_mu, rw_w0, rw_w2, rw_a0, rw_a2, rw_g2,
              rw_kk, rw_ka, rw_rk, rw_lnx_g, rw_lnx_b, rw_v0, rw_v1, rw_v2, wa_sink, mla_qnorm_g, mla_kvnorm_g,
              mla_w_uq, mla_w_ukv, w_branch, w_out, norm2_g, ffn_w_in, ffn_conv_w, ffn_conv_b, ffn_w_out,
              final_norm_g):
    rows = x.shape[1] // GRID_W
    cos_wa, sin_wa = axial_rope_table(rows, WA_HEAD_DIM)
    cos_mla, sin_mla = axial_rope_table(rows, MLA_ROPE)
    xc, xl = ctx, x
    v_first = None
    for l in range(DEPTH):
        need_ctx = l < DEPTH - 1
        mod_l = jnp.split((jax.nn.silu(c) @ ada_w[l] + ada_b[l])[:, None, :], 6, axis=-1)
        mod_c = jnp.split((jax.nn.silu(c_ctx) @ ada_w[l] + ada_b[l])[None, None, :], 6, axis=-1)

        hl = modulate(rmsnorm(xl, norm1_g[l]), mod_l[0], mod_l[1])
        hc = modulate(rmsnorm(xc, norm1_g[l]), mod_c[0], mod_c[1])
        rw_l, wa_l, ml_l, gt_l = split_last(hl @ w_in[l], IN_SPLITS)
        rw_c, wa_c, ml_c, gt_c = split_last(hc @ w_in[l], IN_SPLITS)
        vres = None if l == 0 else (rw_v0[l - 1], rw_v1[l - 1], rw_v2[l - 1])
        oa_c, oa_l, v_first = rwkv7_branch(rw_c, rw_l, v_first, vres, rw_mu[l], rw_w0[l], rw_w2[l], rw_a0[l],
                                           rw_a2[l], rw_g2[l], rw_kk[l], rw_ka[l], rw_rk[l], rw_lnx_g[l], rw_lnx_b[l])
        ob_c, ob_l = windowed_gqa_branch(wa_c, wa_l, wa_sink[l], cos_wa, sin_wa, need_ctx)
        oc_c, oc_l = mla_branch(ml_c, ml_l, mla_qnorm_g[l], mla_kvnorm_g[l], mla_w_uq[l], mla_w_ukv[l],
                                cos_mla, sin_mla, need_ctx)
        xl = xl + mod_l[2] * merge_branches(gt_l, (oa_l, ob_l, oc_l), w_branch[l], w_out[l])

        hl = modulate(rmsnorm(xl, norm2_g[l]), mod_l[3], mod_l[4])
        xl = xl + mod_l[5] * conv_glu(hl, ffn_w_in[l], ffn_conv_w[l], ffn_conv_b[l], ffn_w_out[l])

        if need_ctx:
            xc = xc + mod_c[2] * merge_branches(gt_c, (oa_c, ob_c, oc_c), w_branch[l], w_out[l])
            hc = modulate(rmsnorm(xc, norm2_g[l]), mod_c[3], mod_c[4])
            xc = xc + mod_c[5] * conv_glu(hc, ffn_w_in[l], ffn_conv_w[l], ffn_conv_b[l], ffn_w_out[l])
    return rmsnorm(xl, final_norm_g)
```

```cpp
#include <hip/hip_runtime.h>
#include <hip/hip_bf16.h>
#include <hip/hip_cooperative_groups.h>
#include <cstdio>
#include <cstring>
namespace cg = cooperative_groups;

#ifndef ONE_LAUNCH
#define ONE_LAUNCH 1
#endif

typedef unsigned short bf16_t;
using bf16x8 = __attribute__((ext_vector_type(8))) short;
using f32x4 = __attribute__((ext_vector_type(4))) float;
using f32x16 = __attribute__((ext_vector_type(16))) float;
#define DI __device__ __forceinline__

constexpr int D = 2048, SEQ = 16384, CTXL = 256, SB = 16640, T = 33280;
constexpr int INC = 12288;
constexpr size_t MiB = 1u << 20;
constexpr int LDH = 2112, LDW = 2112, LDWB = 1088, LDUQ = 576, LDA2 = 5696, LDKQ = 1600;
constexpr size_t OFF_W = 0, OFF_SMALL = 78 * MiB, OFF_H = 92 * MiB, OFF_VF = 230 * MiB, OFF_OA = 295 * MiB,
                 OFF_OB = 360 * MiB, OFF_OC = 425 * MiB, OFF_BIG = 490 * MiB;
constexpr size_t W_IN = 0, W_BR = W_IN + (size_t)12288 * LDW * 2, W_OUT = W_BR + (size_t)3 * 2048 * LDWB * 2,
                 W_UQ = W_OUT + (size_t)2048 * LDW * 2, W_UKV = W_UQ + (size_t)1536 * LDUQ * 2,
                 W_W2 = W_UKV + (size_t)2048 * LDUQ * 2, W_A2 = W_W2 + 2 * 1024 * 128 * 2, W_G2 = W_A2 + 2 * 1024 * 128 * 2,
                 W_V1 = W_G2 + 1024 * 64 * 2, W_V2 = W_V1 + 128 * 1024 * 2, W_END = W_V2 + 1024 * 64 * 2;
static_assert(W_END <= 78 * MiB, "W region overflow");
static_assert((size_t)T * LDH * 2 <= (230 - 92) * MiB, "H region overflow");
constexpr size_t S_XC = 0, S_MOD = 4 * MiB, S_COS = 5 * MiB, S_SIN = 7 * MiB, S_SSQ = 9 * MiB, S_TV1 = 9 * MiB + 512 * 1024, S_CNT = 13 * MiB + 768 * 1024;
constexpr size_t B_ZRKV = 0, B_LORA = 195 * MiB, B_EF = 232 * MiB, B_EB = 297 * MiB, B_AF = 362 * MiB, B_AB = 427 * MiB;
constexpr size_t B_QWA = 0, B_KWA = 65 * MiB, B_VTWA = 82 * MiB, B_ZMLA = 99 * MiB, B_QMLA = 169 * MiB,
                 B_KMLA = 271 * MiB, B_VTMLA = 373 * MiB;
static_assert((size_t)T * LDKQ * 2 <= 102 * MiB, "q/k mla overflow");
constexpr size_t B_G = 0, B_A2 = 0, B_WFIN = 362 * MiB, B_WFOUT = 408 * MiB;
static_assert((size_t)T * LDA2 * 2 <= 362 * MiB && (size_t)11264 * LDW * 2 <= 46 * MiB && (size_t)2048 * LDA2 * 2 <= 24 * MiB, "ffn stage overflow");

constexpr float LOG2E = 1.4426950408889634f;
extern "C" __device__ size_t __ockl_get_num_groups(unsigned);
DI int tidx() { int t = __builtin_amdgcn_workitem_id_x(); asm volatile("" : "+v"(t)); return t; }
DI int bidx() { int t = __builtin_amdgcn_workgroup_id_x(); asm volatile("" : "+s"(t)); return t; }
DI int gdim() { int t = (int)__ockl_get_num_groups(0); asm volatile("" : "+s"(t)); return t; }


struct Params {
  const float* in[35];
  float* out;
  char* ws;
  int p0, p1;
};

typedef __bf16 hbf16x2_t __attribute__((ext_vector_type(2)));
typedef float hf32x2_t __attribute__((ext_vector_type(2)));
DI unsigned pack2(float a, float b) {
  hf32x2_t v = {a, b};
  return __builtin_bit_cast(unsigned, __builtin_convertvector(v, hbf16x2_t));
}
DI unsigned short f2bf(float x) { return (unsigned short)(pack2(x, 0.f) & 0xffffu); }
DI float bf2f(unsigned short h) { return __uint_as_float(((unsigned)h) << 16); }
DI float bflo(unsigned u) { return __uint_as_float(u << 16); }
DI float bfhi(unsigned u) { return __uint_as_float(u & 0xffff0000u); }
DI float sigmoidf_(float x) { return __builtin_amdgcn_rcpf(1.f + __expf(-x)); }

template <int CTRL>
DI float dpp_add(float x) {
  int v = __builtin_amdgcn_update_dpp(0, __float_as_int(x), CTRL, 0xF, 0xF, true);
  return x + __int_as_float(v);
}
DI float reduce16(float x) {
  x = dpp_add<0xB1>(x);
  x = dpp_add<0x4E>(x);
  x = dpp_add<0x141>(x);
  x = dpp_add<0x140>(x);
  return x;
}
using u32x4 = __attribute__((ext_vector_type(4))) unsigned;
DI u32x4 gload16(const void* p) { return *(const u32x4*)p; }
typedef __amdgpu_buffer_rsrc_t brsrc_t;
DI brsrc_t make_rsrc(const void* p) { return __builtin_amdgcn_make_buffer_rsrc((void*)p, 0, 0x7fffffff, 0x00020000); }
DI u32x4 bload16(brsrc_t r, unsigned voff, unsigned soff) { return __builtin_amdgcn_raw_buffer_load_b128(r, (int)voff, (int)soff, 0); }
DI void cfence() { asm volatile("" ::: "memory"); }
DI void vm_wait8(u32x4& a, u32x4& b, u32x4& c, u32x4& d, u32x4& e, u32x4& f, u32x4& g, u32x4& h) { cfence(); }
using u32x2 = __attribute__((ext_vector_type(2))) unsigned;
DI u32x2 gload8(const void* p) { return *(const u32x2*)p; }
DI void vm_wait5x2(u32x2& a, u32x2& b, u32x2& c, u32x2& d, u32x2& e) { cfence(); }
DI void vm_wait1(u32x4& a) {}
DI float fma_(float a, float b, float c) { float d; asm("v_fma_f32 %0, %1, %2, %3" : "=v"(d) : "v"(a), "v"(b), "v"(c)); return d; }
DI float mul_(float a, float b) { float d; asm("v_mul_f32 %0, %1, %2" : "=v"(d) : "v"(a), "v"(b)); return d; }
DI float add_(float a, float b) { float d; asm("v_add_f32 %0, %1, %2" : "=v"(d) : "v"(a), "v"(b)); return d; }
DI float sel_mask_(float keep, float take, unsigned long long mask) {
  float d;
  asm("v_cndmask_b32 %0, %1, %2, %3" : "=v"(d) : "v"(keep), "v"(take), "s"(mask));
  return d;
}
DI float add_n_(float a, float b) { float d; asm("v_add_f32 %0, %1, %2\n\ts_nop 1" : "=v"(d) : "v"(a), "v"(b)); return d; }
DI float fma_n_(float a, float b, float c) { float d; asm("v_fma_f32 %0, %1, %2, %3\n\ts_nop 1" : "=v"(d) : "v"(a), "v"(b), "v"(c)); return d; }
DI float xhalf_max(float x) {
  auto r = __builtin_amdgcn_permlane32_swap(__float_as_uint(x), __float_as_uint(x), false, false);
  return fmaxf(__uint_as_float(r[0]), __uint_as_float(r[1]));
}
DI float xhalf_sum(float x) {
  auto r = __builtin_amdgcn_permlane32_swap(__float_as_uint(x), __float_as_uint(x), false, false);
  return __uint_as_float(r[0]) + __uint_as_float(r[1]);
}
DI float wave_sum(float x) {
  x = reduce16(x);
  auto r = __builtin_amdgcn_permlane16_swap(__float_as_uint(x), __float_as_uint(x), false, false);
  x = __uint_as_float(r[0]) + __uint_as_float(r[1]);
  return xhalf_sum(x);
}

DI float* xrow(const Params& P, int row) {
  int b = row / SB, s = row - b * SB;
  if (s < CTXL) return (float*)(P.ws + OFF_SMALL + S_XC) + ((size_t)(b * CTXL + s)) * D;
  return P.out + ((size_t)b * SEQ + (s - CTXL)) * D;
}
DI const float* xrow_in(const Params& P, int row) {
  int b = row / SB, s = row - b * SB;
  if (s < CTXL) return P.in[2] + ((size_t)(b * CTXL + s)) * D;
  return P.in[0] + ((size_t)b * SEQ + (s - CTXL)) * D;
}
DI const float* modvec(const Params& P, int l, int b, int s, int chunk) {
  int vec = (s < CTXL) ? 2 : b;
  return (const float*)(P.ws + OFF_SMALL + S_MOD) + ((size_t)(l * 3 + vec) * INC) + chunk * D;
}

constexpr int TS = 132;
#define MFMA16(a, b, c) __builtin_amdgcn_mfma_f32_16x16x32_bf16((a), (b), (c), 0, 0, 0)
#define MFMA32(a, b, c) __builtin_amdgcn_mfma_f32_32x32x16_bf16((a), (b), (c), 0, 0, 0)

DI void gemm_compute(f32x4 (&acc)[4][4], const char* cA, const char* cB, int fq, int sw) {
  bf16x8 af[2][4], bfr[2][4];
#pragma unroll
  for (int kk = 0; kk < 2; ++kk) {
    const int co = (((kk * 4 + fq) ^ sw) << 4);
#pragma unroll
    for (int m = 0; m < 4; ++m) af[kk][m] = *(const bf16x8*)(cA + m * 2048 + co);
#pragma unroll
    for (int n = 0; n < 4; ++n) bfr[kk][n] = *(const bf16x8*)(cB + n * 2048 + co);
  }
  __builtin_amdgcn_sched_barrier(0);
#pragma unroll
  for (int kk = 0; kk < 2; ++kk)
#pragma unroll
    for (int m = 0; m < 4; ++m)
#pragma unroll
      for (int n = 0; n < 4; ++n) acc[m][n] = MFMA16(af[kk][m], bfr[kk][n], acc[m][n]);
}

DI void gemm_kloop(f32x4 (&acc)[4][4], const bf16_t* __restrict__ A, int lda, const bf16_t* __restrict__ Bt, int ldb,
                   int K, int b, int s0, int col0, char* smem) {
  const int tid = tidx(), lane = tid & 63, wid = tid >> 6;
  const int wr = wid >> 1, wc = wid & 1, fr = lane & 15, fq = lane >> 4;
  const int lrow = tid >> 3, lkc = tid & 7;
  const bf16_t* ap[4];
#pragma unroll
  for (int j = 0; j < 4; ++j) {
    int s = s0 + lrow + 32 * j;
    s = s < 0 ? 0 : (s > SB - 1 ? SB - 1 : s);
    ap[j] = A + (size_t)(b * SB + s) * lda + lkc * 8;
  }
  const bf16_t* bp = Bt + (size_t)(col0 + lrow) * ldb + lkc * 8;
  const size_t bstep = (size_t)32 * ldb;
  const int wofs = lrow * 128 + ((lkc ^ ((lrow >> 1) & 7)) << 4);
  char* sA = smem;
  char* sB = smem + 32768;
  const int nk = K >> 6;
  u32x4 xa[4], xb[4], ya[4], yb[4];
#define GLOAD(RA, RB, KT)                                        \
  {                                                              \
    const int kn_ = ((KT) < nk) ? (KT) : nk - 1;                 \
    _Pragma("unroll") for (int j = 0; j < 4; ++j) {              \
      RA[j] = gload16(ap[j] + kn_ * 64);                         \
      RB[j] = gload16(bp + j * bstep + kn_ * 64);                \
    }                                                            \
  }
#define LSTORE(RA, RB, P)                                        \
  {                                                              \
    char* dA_ = sA + (P) * 16384 + wofs;                         \
    char* dB_ = sB + (P) * 16384 + wofs;                         \
    _Pragma("unroll") for (int j = 0; j < 4; ++j) {              \
      *(u32x4*)(dA_ + j * 4096) = RA[j];                         \
      *(u32x4*)(dB_ + j * 4096) = RB[j];                         \
    }                                                            \
  }
  GLOAD(xa, xb, 0);
  GLOAD(ya, yb, 1);
  cfence();
  LSTORE(xa, xb, 0);
  __syncthreads();
  const int aofs = (wr * 64 + fr) * 128, bofs = (wc * 64 + fr) * 128, sw = (fr >> 1) & 7;
  for (int kt = 0; kt < nk; kt += 2) {
    GLOAD(xa, xb, kt + 2);
    cfence();
    gemm_compute(acc, sA + aofs, sB + bofs, fq, sw);
    LSTORE(ya, yb, 1);
    __syncthreads();
    if (kt + 1 < nk) {
      GLOAD(ya, yb, kt + 3);
      cfence();
      gemm_compute(acc, sA + 16384 + aofs, sB + 16384 + bofs, fq, sw);
      LSTORE(xa, xb, 0);
      __syncthreads();
    }
  }
#undef GLOAD
#undef LSTORE
}

DI void gemm_kloop1(f32x4 (&acc)[4][4], const bf16_t* __restrict__ A, int lda, const bf16_t* __restrict__ Bt, int ldb,
                   int K, int b, int s0, int col0, char* smem) {
  const int tid = tidx(), lane = tid & 63, wid = tid >> 6;
  const int wr = wid >> 1, wc = wid & 1, fr = lane & 15, fq = lane >> 4;
  const int lrow = tid >> 3, lkc = tid & 7;
  const brsrc_t rA = make_rsrc(A), rB = make_rsrc(Bt);
  unsigned aoff[4];
#pragma unroll
  for (int j = 0; j < 4; ++j) {
    int s = s0 + lrow + 32 * j;
    s = s < 0 ? 0 : (s > SB - 1 ? SB - 1 : s);
    aoff[j] = ((unsigned)(b * SB + s) * (unsigned)lda + lkc * 8) * 2u;
  }
  const unsigned boff = ((unsigned)(col0 + lrow) * (unsigned)ldb + lkc * 8) * 2u;
  const unsigned bstep = 32u * (unsigned)ldb * 2u;
  const int wofs = lrow * 128 + ((lkc ^ ((lrow >> 1) & 7)) << 4);
  char* sA = smem;
  char* sB = smem + 32768;
  const int nk = K >> 6;
  u32x4 ra[4], rb[4];
#pragma unroll
  for (int j = 0; j < 4; ++j) {
    ra[j] = bload16(rA, aoff[j], 0u);
    rb[j] = bload16(rB, boff + j * bstep, 0u);
  }
  vm_wait8(ra[0], ra[1], ra[2], ra[3], rb[0], rb[1], rb[2], rb[3]);
#pragma unroll
  for (int j = 0; j < 4; ++j) {
    *(u32x4*)(sA + wofs + j * 4096) = ra[j];
    *(u32x4*)(sB + wofs + j * 4096) = rb[j];
  }
  __syncthreads();
  const int aofs = (wr * 64 + fr) * 128, bofs = (wc * 64 + fr) * 128, sw = (fr >> 1) & 7;
  for (int kt = 0; kt < nk; ++kt) {
    const int p = kt & 1;
    {
      const int kn = (kt + 1 < nk) ? kt + 1 : kt;
#pragma unroll
      for (int j = 0; j < 4; ++j) {
        ra[j] = bload16(rA, aoff[j], (unsigned)kn * 128u);
        rb[j] = bload16(rB, boff + j * bstep, (unsigned)kn * 128u);
      }
    }
    cfence();
    const char* cA = sA + p * 16384 + aofs;
    const char* cB = sB + p * 16384 + bofs;
#pragma unroll
    for (int kk = 0; kk < 2; ++kk) {
      bf16x8 af[4], bfr[4];
      const int co = (((kk * 4 + fq) ^ sw) << 4);
#pragma unroll
      for (int m = 0; m < 4; ++m) af[m] = *(const bf16x8*)(cA + m * 2048 + co);
#pragma unroll
      for (int n = 0; n < 4; ++n) bfr[n] = *(const bf16x8*)(cB + n * 2048 + co);
#pragma unroll
      for (int m = 0; m < 4; ++m)
#pragma unroll
        for (int n = 0; n < 4; ++n) acc[m][n] = MFMA16(af[m], bfr[n], acc[m][n]);
    }
    {
      char* dA = sA + (p ^ 1) * 16384 + wofs;
      char* dB = sB + (p ^ 1) * 16384 + wofs;
      vm_wait8(ra[0], ra[1], ra[2], ra[3], rb[0], rb[1], rb[2], rb[3]);
#pragma unroll
      for (int j = 0; j < 4; ++j) {
        *(u32x4*)(dA + j * 4096) = ra[j];
        *(u32x4*)(dB + j * 4096) = rb[j];
      }
    }
    __syncthreads();
  }
}

DI void zero_acc(f32x4 (&acc)[4][4]) {
#pragma unroll
  for (int m = 0; m < 4; ++m)
#pragma unroll
    for (int n = 0; n < 4; ++n) acc[m][n] = f32x4{0.f, 0.f, 0.f, 0.f};
}

DI void acc_to_tile(const f32x4 (&acc)[4][4], float* tile) {
  const int tid = tidx(), lane = tid & 63, wid = tid >> 6;
  const int wr = wid >> 1, wc = wid & 1, fr = lane & 15, fq = lane >> 4;
#pragma unroll
  for (int m = 0; m < 4; ++m)
#pragma unroll
    for (int n = 0; n < 4; ++n)
#pragma unroll
      for (int j = 0; j < 4; ++j) tile[(wr * 64 + m * 16 + fq * 4 + j) * TS + wc * 64 + n * 16 + fr] = acc[m][n][j];
}

DI int swz4(int row) { const int g = (row >> 2) & 3; return ((g << 1) ^ ((g >> 1) * 3)) & 3; }
DI void gemm256_kloop(f32x4 (&acc)[8][4], const bf16_t* __restrict__ A, int lda, const bf16_t* __restrict__ Bt, int ldb,
                      int K, int b, int s0, int col0, char* smem) {
  const int tid = tidx(), lane = tid & 63, wid = tid >> 6;
  const int wr = wid >> 1, wc = wid & 1, fr = lane & 15, fq = lane >> 4;
  const int lrow = tid >> 2, lkc = tid & 3;
  const brsrc_t rA = make_rsrc(A), rB = make_rsrc(Bt);
  unsigned aoff[4];
#pragma unroll
  for (int j = 0; j < 4; ++j) {
    int s = s0 + lrow + 64 * j;
    s = s < 0 ? 0 : (s > SB - 1 ? SB - 1 : s);
    aoff[j] = ((unsigned)(b * SB + s) * (unsigned)lda + lkc * 8) * 2u;
  }
  const unsigned boff = ((unsigned)(col0 + lrow) * (unsigned)ldb + lkc * 8) * 2u;
  const unsigned bstep = 64u * (unsigned)ldb * 2u;
  const int wofs = lrow * 64 + ((lkc ^ swz4(lrow)) << 4);
  const int nk = K >> 5;
  u32x4 xa[4], xb[2], ya[4], yb[2];
#define GLOAD2(RA, RB, KT)                                       \
  {                                                              \
    const int kn_ = ((KT) < nk) ? (KT) : nk - 1;                 \
    _Pragma("unroll") for (int j = 0; j < 4; ++j) RA[j] = bload16(rA, aoff[j], (unsigned)kn_ * 64u); \
    _Pragma("unroll") for (int j = 0; j < 2; ++j) RB[j] = bload16(rB, boff + j * bstep, (unsigned)kn_ * 64u); \
  }
#define LSTORE2(RA, RB, P)                                       \
  {                                                              \
    char* dA_ = smem + (P) * 24576 + wofs;                       \
    _Pragma("unroll") for (int j = 0; j < 4; ++j) *(u32x4*)(dA_ + j * 4096) = RA[j]; \
    _Pragma("unroll") for (int j = 0; j < 2; ++j) *(u32x4*)(dA_ + 16384 + j * 4096) = RB[j]; \
  }
#define COMPUTE2(P)                                              \
  {                                                              \
    const char* cA_ = smem + (P) * 24576 + aofs;                 \
    const char* cB_ = smem + (P) * 24576 + 16384 + bofs;         \
    bf16x8 af_[8], bf_[4];                                       \
    _Pragma("unroll") for (int m = 0; m < 8; ++m) af_[m] = *(const bf16x8*)(cA_ + m * 1024); \
    _Pragma("unroll") for (int n = 0; n < 4; ++n) bf_[n] = *(const bf16x8*)(cB_ + n * 1024); \
    __builtin_amdgcn_s_setprio(1);                               \
    _Pragma("unroll") for (int m = 0; m < 8; ++m)                \
      _Pragma("unroll") for (int n = 0; n < 4; ++n) acc[m][n] = MFMA16(af_[m], bf_[n], acc[m][n]); \
    __builtin_amdgcn_s_setprio(0);                               \
  }
  GLOAD2(xa, xb, 0);
  GLOAD2(ya, yb, 1);
  cfence();
  LSTORE2(xa, xb, 0);
  __syncthreads();
  const int co = ((fq ^ swz4(fr)) << 4);
  const int aofs = (wr * 128 + fr) * 64 + co, bofs = (wc * 64 + fr) * 64 + co;
  for (int kt = 0; kt < nk; kt += 2) {
    GLOAD2(xa, xb, kt + 2);
    cfence();
    COMPUTE2(0);
    LSTORE2(ya, yb, 1);
    __syncthreads();
    if (kt + 1 < nk) {
      GLOAD2(ya, yb, kt + 3);
      cfence();
      COMPUTE2(1);
      LSTORE2(xa, xb, 0);
      __syncthreads();
    }
  }
#undef GLOAD2
#undef LSTORE2
#undef COMPUTE2
}

DI void acc256_to_tile(const f32x4 (&acc)[8][4], float* tile, int rowoff) {
  const int tid = tidx(), lane = tid & 63, wid = tid >> 6;
  const int wr = wid >> 1, wc = wid & 1, fr = lane & 15, fq = lane >> 4;
#pragma unroll
  for (int m = 0; m < 8; ++m) {
    const int i0 = wr * 128 + m * 16 + fq * 4 - rowoff;
#pragma unroll
    for (int j = 0; j < 4; ++j) {
      const int i = i0 + j;
      if (i >= 0 && i < 128) {
#pragma unroll
        for (int n = 0; n < 4; ++n) tile[i * TS + wc * 64 + n * 16 + fr] = acc[m][n][j];
      }
    }
  }
}

template <class Epi>
DI void gemm256_tile(const bf16_t* A, int lda, const bf16_t* Bt, int ldb, int K, int b, int s0, int col0, char* smem,
                     const Epi& epi, int rstep) {
  f32x4 acc[8][4];
#pragma unroll
  for (int m = 0; m < 8; ++m)
#pragma unroll
    for (int n = 0; n < 4; ++n) acc[m][n] = f32x4{0.f, 0.f, 0.f, 0.f};
  gemm256_kloop(acc, A, lda, Bt, ldb, K, b, s0, col0, smem);
  float* tile = (float*)smem;
#pragma unroll 1
  for (int pass = 0; pass < 2; ++pass) {
    acc256_to_tile(acc, tile, pass * rstep);
    __syncthreads();
    epi(tile, b, s0 + pass * rstep, col0);
    __syncthreads();
  }
}
template <class Epi>
DI void gemm256_item_plain(const bf16_t* A, int lda, const bf16_t* Bt, int ldb, int K, int ntn, char* smem, const Epi& epi, int it) {
  int mt = it / ntn, nt = it - mt * ntn;
  int b = mt / 65, s0 = (mt - b * 65) * 256;
  gemm256_tile(A, lda, Bt, ldb, K, b, s0, nt * 128, smem, epi, 128);
}
template <class Epi>
DI void gemm256_phase_plain(const bf16_t* A, int lda, const bf16_t* Bt, int ldb, int K, int ntn, char* smem, const Epi& epi,
                            bool skip_ctx = false) {
  if (!skip_ctx) {
    const int total = 130 * ntn;
    for (int it = bidx(); it < total; it += gdim()) gemm256_item_plain(A, lda, Bt, ldb, K, ntn, smem, epi, it);
  } else {
    const int total = 128 * ntn;
    for (int it = bidx(); it < total; it += gdim()) {
      const int mt = it / ntn, nt = it - mt * ntn;
      const int mt2 = mt + 1 + (mt >= 64 ? 1 : 0);
      gemm256_item_plain(A, lda, Bt, ldb, K, ntn, smem, epi, mt2 * ntn + nt);
    }
  }
}
template <class Epi>
DI void gemm256_phase_overlap(const bf16_t* A, int lda, const bf16_t* Bt, int ldb, int K, int ntn, char* smem, const Epi& epi) {
  const int total = 134 * ntn;
  for (int it = bidx(); it < total; it += gdim()) {
    int mt = it / ntn, nt = it - mt * ntn;
    int b = mt / 67, s0 = (mt - b * 67) * 252 - 1;
    gemm256_tile(A, lda, Bt, ldb, K, b, s0, nt * 128, smem, epi, 126);
  }
}

template <class Epi>
DI void gemm_tile(const bf16_t* A, int lda, const bf16_t* Bt, int ldb, int K, int b, int s0, int col0, char* smem,
                  const Epi& epi) {
  f32x4 acc[4][4];
  zero_acc(acc);
  gemm_kloop(acc, A, lda, Bt, ldb, K, b, s0, col0, smem);
  float* tile = (float*)smem;
  acc_to_tile(acc, tile);
  __syncthreads();
  epi(tile, b, s0, col0);
  __syncthreads();
}

DI bool same_dom(int s1, int s2) { return (s1 >= 0) && (s1 < SB) && (s2 >= 0) && (s2 < SB) && ((s1 < CTXL) == (s2 < CTXL)); }

struct EpiStore {
  bf16_t* dst; int ldd; int ncols;
  DI void operator()(const float* tile, int b, int s0, int col0) const {
    const int t = tidx(), c8 = (t & 15) * 8;
    const int n = col0 + c8;
    if (n >= ncols) return;
    for (int i = t >> 4; i < 128; i += 16) {
      size_t row = (size_t)b * SB + s0 + i;
      const float4 a = *(const float4*)(tile + i * TS + c8), c = *(const float4*)(tile + i * TS + c8 + 4);
      *(uint4*)(dst + row * ldd + n) = uint4{pack2(a.x, a.y), pack2(a.z, a.w), pack2(c.x, c.y), pack2(c.z, c.w)};
    }
  }
};

struct EpiRW {
  const float* mu; bf16_t* zrkv; bf16_t* lora; bf16_t* vf;
  DI void operator()(const float* tile, int b, int s0, int col0) const {
    if (col0 < 3072) {
      const int t = tidx(), c8 = (t & 15) * 8, n = col0 + c8;
      float m8[8];
      *(float4*)(m8) = *(const float4*)(mu + n); *(float4*)(m8 + 4) = *(const float4*)(mu + n + 4);
      for (int i = 1 + (t >> 4); i <= 126; i += 16) {
        const int s = s0 + i;
        if (s >= SB) break;
        const float* tr = tile + i * TS + c8;
        const bool hm = same_dom(s - 1, s), hp = same_dom(s + 1, s);
        float z[8], zm[8], zp[8];
        *(float4*)(z) = *(const float4*)(tr); *(float4*)(z + 4) = *(const float4*)(tr + 4);
        *(float4*)(zm) = *(const float4*)(tr - TS); *(float4*)(zm + 4) = *(const float4*)(tr - TS + 4);
        *(float4*)(zp) = *(const float4*)(tr + TS); *(float4*)(zp + 4) = *(const float4*)(tr + TS + 4);
        float o[8];
#pragma unroll
        for (int e = 0; e < 8; ++e) {
          const float nb = (hm ? zm[e] : 0.f) + (hp ? zp[e] : 0.f);
          o[e] = z[e] + m8[e] * (0.5f * nb - z[e]);
        }
        const size_t row = (size_t)b * SB + s;
        const uint4 pk = uint4{pack2(o[0], o[1]), pack2(o[2], o[3]), pack2(o[4], o[5]), pack2(o[6], o[7])};
        *(uint4*)(zrkv + row * 3072 + n) = pk;
        if (vf != nullptr && n >= 2048) *(uint4*)(vf + row * 1024 + (n - 2048)) = pk;
      }
      return;
    }
    const int t = tidx(), c2 = (t & 63) * 2;
    const int n = col0 + c2;
    if (n >= 3520) return;
    const float mu0 = mu[n], mu1 = mu[n + 1];
    for (int i = 1 + (t >> 6); i <= 126; i += 4) {
      const int s = s0 + i;
      if (s >= SB) break;
      const float* tr = tile + i * TS + c2;
      float z0 = tr[0], z1 = tr[1];
      float m0 = 0.f, m1 = 0.f, p0 = 0.f, p1 = 0.f;
      if (same_dom(s - 1, s)) { m0 = tr[-TS]; m1 = tr[-TS + 1]; }
      if (same_dom(s + 1, s)) { p0 = tr[TS]; p1 = tr[TS + 1]; }
      z0 = z0 + mu0 * (0.5f * (m0 + p0) - z0);
      z1 = z1 + mu1 * (0.5f * (m1 + p1) - z1);
      const size_t row = (size_t)b * SB + s;
      if (n < 3072) {
        unsigned pk = pack2(z0, z1);
        *(unsigned*)(zrkv + row * 3072 + n) = pk;
        if (vf != nullptr && n >= 2048) *(unsigned*)(vf + row * 1024 + (n - 2048)) = pk;
      } else if (n < 3456) {
        const int j = (n - 3072) / 96, kk = (n - 3072) - j * 96;
        if (j < 2) { z0 = 2.f * sigmoidf_(2.f * z0) - 1.f; z1 = 2.f * sigmoidf_(2.f * z1) - 1.f; }
        *(unsigned*)(lora + row * 576 + j * 128 + kk) = pack2(z0, z1);
        if (kk < 32) *(unsigned*)(lora + row * 576 + j * 128 + 96 + kk) = 0u;
      } else {
        *(unsigned*)(lora + row * 576 + 512 + (n - 3456)) = pack2(sigmoidf_(z0), sigmoidf_(z1));
      }
    }
  }
};

struct EpiDecay {
  const float* w0; bf16_t* dst;
  DI void operator()(const float* tile, int b, int s0, int col0) const {
    const int t = tidx(), c8 = (t & 15) * 8, n = col0 + c8;
    const float4 ba = *(const float4*)(w0 + n), bc = *(const float4*)(w0 + n + 4);
    const float k = 0.6065306597126334f;
    for (int i = t >> 4; i < 128; i += 16) {
      size_t row = (size_t)b * SB + s0 + i;
      const float4 a = *(const float4*)(tile + i * TS + c8), c = *(const float4*)(tile + i * TS + c8 + 4);
      *(uint4*)(dst + row * 1024 + n) =
          uint4{pack2(k * sigmoidf_(ba.x + a.x), k * sigmoidf_(ba.y + a.y)), pack2(k * sigmoidf_(ba.z + a.z), k * sigmoidf_(ba.w + a.w)),
                pack2(k * sigmoidf_(bc.x + c.x), k * sigmoidf_(bc.y + c.y)), pack2(k * sigmoidf_(bc.z + c.z), k * sigmoidf_(bc.w + c.w))};
    }
  }
};
struct EpiSigBias {
  const float* bias; bf16_t* dst; int ldd;
  DI void operator()(const float* tile, int b, int s0, int col0) const {
    const int t = tidx(), c8 = (t & 15) * 8, n = col0 + c8;
    float4 ba = {0.f, 0.f, 0.f, 0.f}, bc = {0.f, 0.f, 0.f, 0.f};
    if (bias) { ba = *(const float4*)(bias + n); bc = *(const float4*)(bias + n + 4); }
    for (int i = t >> 4; i < 128; i += 16) {
      size_t row = (size_t)b * SB + s0 + i;
      const float4 a = *(const float4*)(tile + i * TS + c8), c = *(const float4*)(tile + i * TS + c8 + 4);
      *(uint4*)(dst + row * ldd + n) =
          uint4{pack2(sigmoidf_(ba.x + a.x), sigmoidf_(ba.y + a.y)), pack2(sigmoidf_(ba.z + a.z), sigmoidf_(ba.w + a.w)),
                pack2(sigmoidf_(bc.x + c.x), sigmoidf_(bc.y + c.y)), pack2(sigmoidf_(bc.z + c.z), sigmoidf_(bc.w + c.w))};
    }
  }
};
struct EpiVres {
  const float* v0; bf16_t* zrkv; const bf16_t* vf;
  DI void operator()(const float* tile, int b, int s0, int col0) const {
    const int t = tidx(), c2 = (t & 63) * 2, n = col0 + c2;
    const float b0 = v0[n], b1 = v0[n + 1];
    for (int i = t >> 6; i < 128; i += 4) {
      size_t row = (size_t)b * SB + s0 + i;
      unsigned* pv = (unsigned*)(zrkv + row * 3072 + 2048 + n);
      unsigned uv = *pv, uf = *(const unsigned*)(vf + row * 1024 + n);
      float va = bflo(uv), vb = bfhi(uv), fa = bflo(uf), fb = bfhi(uf);
      va = va + (fa - va) * sigmoidf_(b0 + tile[i * TS + c2]);
      vb = vb + (fb - vb) * sigmoidf_(b1 + tile[i * TS + c2 + 1]);
      *pv = pack2(va, vb);
    }
  }
};

DI void rope_pair(float& a, float& bb, const float* cs, const float* sn, int t, int d) {
  float c = cs[t * 32 + d], s = sn[t * 32 + d];
  float x = a * c - bb * s, y = a * s + bb * c;
  a = x; bb = y;
}

struct EpiWA {
  bf16_t* q; bf16_t* k; bf16_t* vt; const float* cs; const float* sn;
  DI void operator()(const float* tile, int b, int s0, int col0) const {
    const int t = tidx();
    if (col0 < 1280) {
      const int hb = (t >> 5) & 1, d = t & 31;
      const float scl = (col0 < 1024) ? 0.125f * LOG2E : 1.f;
      for (int i = t >> 6; i < 128; i += 4) {
        const int s = s0 + i;
        float a = tile[i * TS + hb * 64 + d], bb = tile[i * TS + hb * 64 + d + 32];
        if (s >= CTXL) rope_pair(a, bb, cs, sn, s - CTXL, d);
        a *= scl; bb *= scl;
        size_t row = (size_t)b * SB + s;
        bf16_t* dst = (col0 < 1024) ? (q + row * 1024 + col0 + hb * 64) : (k + row * 256 + (col0 - 1024) + hb * 64);
        dst[d] = f2bf(a);
        dst[d + 32] = f2bf(bb);
      }
    } else {
      const int c = t >> 1, half = t & 1;
      bf16_t* dst = vt + ((size_t)b * 256 + (col0 - 1280) + c) * SB + s0 + half * 64;
      for (int g = 0; g < 8; ++g) {
        unsigned w[4];
#pragma unroll
        for (int e = 0; e < 4; ++e) {
          int i = half * 64 + g * 8 + e * 2;
          w[e] = pack2(tile[i * TS + c], tile[(i + 1) * TS + c]);
        }
        *(uint4*)(dst + g * 8) = uint4{w[0], w[1], w[2], w[3]};
      }
    }
  }
};

struct EpiMLAin {
  bf16_t* z; float* ssq;
  DI void operator()(const float* tile, int b, int s0, int col0) const {
    const int t = tidx(), c2 = (t & 63) * 2;
    const int n = col0 + c2;
    const int seg = col0 >> 9;
    for (int i = t >> 6; i < 128; i += 4) {
      size_t row = (size_t)b * SB + s0 + i;
      float v0 = tile[i * TS + c2], v1 = tile[i * TS + c2 + 1];
      if (n < 1088) *(unsigned*)(z + row * 1088 + n) = pack2(v0, v1);
      if (seg < 2) {
        float ss = wave_sum(v0 * v0 + v1 * v1);
        if ((t & 63) == 0) atomicAdd(ssq + row * 2 + seg, ss);
      }
    }
  }
};

struct EpiUQ {
  bf16_t* q; const float* ssq; const float* cs; const float* sn;
  DI void operator()(const float* tile, int b, int s0, int col0) const {
    const int t = tidx(), hb = (t >> 5) & 1, d = t & 31;
    const int blk64 = (col0 >> 6) + hb;
    const bool roped = (blk64 % 3) == 2;
    const float scl = 0.07216878364870322f * LOG2E;
    for (int i = t >> 6; i < 128; i += 4) {
      const int s = s0 + i;
      size_t row = (size_t)b * SB + s;
      float rs = rsqrtf(ssq[row * 2] * (1.f / 512.f) + 1e-6f);
      float a = tile[i * TS + hb * 64 + d] * rs, bb = tile[i * TS + hb * 64 + d + 32] * rs;
      if (roped && s >= CTXL) rope_pair(a, bb, cs, sn, s - CTXL, d);
      bf16_t* dst = q + row * LDKQ + col0 + hb * 64;
      dst[d] = f2bf(a * scl);
      dst[d + 32] = f2bf(bb * scl);
    }
  }
};

struct EpiUKV {
  bf16_t* k; bf16_t* vt; const float* ssq;
  DI void operator()(const float* tile, int b, int s0, int col0) const {
    const int t = tidx();
    const int h = col0 >> 8;
    if (((col0 >> 7) & 1) == 0) {
      const int c8 = (t & 15) * 8;
      for (int i = t >> 4; i < 128; i += 16) {
        size_t row = (size_t)b * SB + s0 + i;
        float rs = rsqrtf(ssq[row * 2 + 1] * (1.f / 512.f) + 1e-6f);
        const float4 a = *(const float4*)(tile + i * TS + c8), c = *(const float4*)(tile + i * TS + c8 + 4);
        *(uint4*)(k + row * LDKQ + h * 192 + c8) =
            uint4{pack2(a.x * rs, a.y * rs), pack2(a.z * rs, a.w * rs), pack2(c.x * rs, c.y * rs), pack2(c.z * rs, c.w * rs)};
      }
    } else {
      const int c = t >> 1, half = t & 1;
      bf16_t* dst = vt + ((size_t)b * 1024 + h * 128 + c) * SB + s0 + half * 64;
      for (int g = 0; g < 8; ++g) {
        unsigned w[4];
#pragma unroll
        for (int e = 0; e < 4; ++e) {
          int i = half * 64 + g * 8 + e * 2;
          size_t row = (size_t)b * SB + s0 + i;
          float rs0 = rsqrtf(ssq[row * 2 + 1] * (1.f / 512.f) + 1e-6f);
          float rs1 = rsqrtf(ssq[(row + 1) * 2 + 1] * (1.f / 512.f) + 1e-6f);
          w[e] = pack2(tile[i * TS + c] * rs0, tile[(i + 1) * TS + c] * rs1);
        }
        *(uint4*)(dst + g * 8) = uint4{w[0], w[1], w[2], w[3]};
      }
    }
  }
};

struct EpiResid {
  const Params* P; int l; int chunk; bool from_input;
  DI void operator()(const float* tile, int b, int s0, int col0) const {
    const int t = tidx(), c4 = (t & 31) * 4, n = col0 + c4;
    for (int i = t >> 5; i < 128; i += 8) {
      const int s = s0 + i;
      const int row = b * SB + s;
      const float* mv = modvec(*P, l, b, s, chunk);
      const float* src = from_input ? xrow_in(*P, row) : xrow(*P, row);
      float* dst = xrow(*P, row);
      const float4 xs = *(const float4*)(src + n), m4 = *(const float4*)(mv + n), a = *(const float4*)(tile + i * TS + c4);
      *(float4*)(dst + n) = float4{xs.x + m4.x * a.x, xs.y + m4.y * a.y, xs.z + m4.z * a.z, xs.w + m4.w * a.w};
    }
  }
};

struct EpiFFNin {
  const float* cw; const float* cb; bf16_t* a2;
  DI void operator()(const float* tile, int b, int s0, int col0) const {
    const int t = tidx(), c8 = (t & 7) * 8;
    const int ch = (col0 >> 7) * 64 + c8;
    float w0[8], w1[8], w2[8], bs[8];
#pragma unroll
    for (int e = 0; e < 8; ++e) { w0[e] = cw[ch + e]; w1[e] = cw[5632 + ch + e]; w2[e] = cw[2 * 5632 + ch + e]; bs[e] = cb[ch + e]; }
    for (int i = 1 + (t >> 3); i <= 126; i += 32) {
      const int s = s0 + i;
      if (s >= SB) break;
      const float* tr = tile + i * TS + c8;
      const bool hm = same_dom(s - 1, s), hp = same_dom(s + 1, s);
      float gm[8], g0[8], gp[8], u[8];
      *(float4*)(g0) = *(const float4*)(tr); *(float4*)(g0 + 4) = *(const float4*)(tr + 4);
      *(float4*)(u) = *(const float4*)(tr + 64); *(float4*)(u + 4) = *(const float4*)(tr + 68);
      *(float4*)(gm) = *(const float4*)(tr - TS); *(float4*)(gm + 4) = *(const float4*)(tr - TS + 4);
      *(float4*)(gp) = *(const float4*)(tr + TS); *(float4*)(gp + 4) = *(const float4*)(tr + TS + 4);
      float o[8];
#pragma unroll
      for (int e = 0; e < 8; ++e) {
        float a = bs[e] + w1[e] * g0[e];
        if (hm) a += w0[e] * gm[e];
        if (hp) a += w2[e] * gp[e];
        float inner = 0.7978845608028654f * (a + 0.044715f * a * a * a);
        o[e] = a * sigmoidf_(2.f * inner) * u[e];
      }
      *(uint4*)(a2 + ((size_t)b * SB + s) * LDA2 + ch) = uint4{pack2(o[0], o[1]), pack2(o[2], o[3]), pack2(o[4], o[5]), pack2(o[6], o[7])};
    }
  }
};

DI void conv_tile(const float* __restrict__ src, int Ksrc, int N, bf16_t* __restrict__ dst, int ldd, int kt, int nt, int perm,
                  const float* kscale, float* sm) {
  const int tid = tidx();
  const int k0 = kt * 64, n0 = nt * 64;
  {
    const int j = tid & 63;
    for (int i = tid >> 6; i < 64; i += 4) {
      float v = 0.f;
      if (k0 + i < Ksrc) {
        v = src[(size_t)(k0 + i) * N + n0 + j];
        if (kscale) v *= kscale[k0 + i];
      }
      sm[i * 65 + j] = v;
    }
  }
  __syncthreads();
  int r0 = n0;
  if (perm) r0 = (n0 < 5632) ? ((n0 >> 6) * 128) : ((((n0 - 5632) >> 6) * 128) + 64);
  {
    const int i2 = (tid & 31) * 2;
    for (int j = tid >> 5; j < 64; j += 8)
      *(unsigned*)(dst + (size_t)(r0 + j) * ldd + k0 + i2) = pack2(sm[i2 * 65 + j], sm[(i2 + 1) * 65 + j]);
  }
  __syncthreads();
}

DI void conv_tile_w(const float* __restrict__ src, int Ksrc, int N, bf16_t* __restrict__ dst, int ldd, int kt, int nt, int perm,
                    const float* kscale, float* sm) {
  const int tid = tidx();
  const int k0 = kt * 64, n0 = nt * 128;
  {
    const int j2 = (tid & 63) * 2;
    for (int i = tid >> 6; i < 64; i += 4) {
      float2 v = {0.f, 0.f};
      if (k0 + i < Ksrc) {
        v = *(const float2*)(src + (size_t)(k0 + i) * N + n0 + j2);
        if (kscale) { const float ks = kscale[k0 + i]; v.x *= ks; v.y *= ks; }
      }
      sm[i * 129 + j2] = v.x;
      sm[i * 129 + j2 + 1] = v.y;
    }
  }
  __syncthreads();
  {
    const int i2 = (tid & 31) * 2;
    for (int j = tid >> 5; j < 128; j += 8) {
      const int n = n0 + j;
      int r = n;
      if (perm) r = (n < 5632) ? ((n >> 6) * 128 + (n & 63)) : ((((n - 5632) >> 6) * 128) + 64 + ((n - 5632) & 63));
      *(unsigned*)(dst + (size_t)r * ldd + k0 + i2) = pack2(sm[i2 * 129 + j], sm[(i2 + 1) * 129 + j]);
    }
  }
  __syncthreads();
}

struct ConvJob { const float* src; bf16_t* dst; int K, N, ldd, perm; const float* ks; };
DI int job_tiles(const ConvJob& j) { return ((j.K + 63) >> 6) * ((j.N & 127) ? (j.N >> 6) : (j.N >> 7)); }
DI void run_job_tile(const ConvJob& j, int t, float* sm) {
  if (j.N & 127) {
    const int ntn = j.N >> 6;
    conv_tile(j.src, j.K, j.N, j.dst, j.ldd, t / ntn, t % ntn, j.perm, j.ks, sm);
  } else {
    const int ntn = j.N >> 7;
    conv_tile_w(j.src, j.K, j.N, j.dst, j.ldd, t / ntn, t % ntn, j.perm, j.ks, sm);
  }
}
DI bool get_wjob(const Params& P, int l, int j, ConvJob& o) {
  char* W = P.ws + OFF_W;
  switch (j) {
    case 0: o = ConvJob{P.in[7] + (size_t)l * D * INC, (bf16_t*)(W + W_IN), D, INC, LDW, 0, nullptr}; return true;
    case 1: case 2: case 3:
      o = ConvJob{P.in[27] + ((size_t)l * 3 + (j - 1)) * 1024 * D, (bf16_t*)(W + W_BR) + (size_t)(j - 1) * D * LDWB, 1024, D, LDWB, 0, nullptr}; return true;
    case 4: o = ConvJob{P.in[28] + (size_t)l * D * D, (bf16_t*)(W + W_OUT), D, D, LDW, 0, nullptr}; return true;
    case 5: o = ConvJob{P.in[25] + (size_t)l * 512 * 1536, (bf16_t*)(W + W_UQ), 512, 1536, LDUQ, 0, P.in[23] + l * 512}; return true;
    case 6: o = ConvJob{P.in[26] + (size_t)l * 512 * 2048, (bf16_t*)(W + W_UKV), 512, 2048, LDUQ, 0, P.in[24] + l * 512}; return true;
    case 7: case 8:
      o = ConvJob{P.in[10] + ((size_t)l * 2 + (j - 7)) * 96 * 1024, (bf16_t*)(W + W_W2) + (size_t)(j - 7) * 1024 * 128, 96, 1024, 128, 0, nullptr}; return true;
    case 9: case 10:
      o = ConvJob{P.in[12] + ((size_t)l * 2 + (j - 9)) * 96 * 1024, (bf16_t*)(W + W_A2) + (size_t)(j - 9) * 1024 * 128, 96, 1024, 128, 0, nullptr}; return true;
    case 11: o = ConvJob{P.in[13] + (size_t)l * 64 * 1024, (bf16_t*)(W + W_G2), 64, 1024, 64, 0, nullptr}; return true;
    case 12: if (l < 1) return false;
      o = ConvJob{P.in[20] + (size_t)(l - 1) * 1024 * 64, (bf16_t*)(W + W_V1), 1024, 64, 1024, 0, nullptr}; return true;
    case 13: if (l < 1) return false;
      o = ConvJob{P.in[21] + (size_t)(l - 1) * 64 * 1024, (bf16_t*)(W + W_V2), 64, 1024, 64, 0, nullptr}; return true;
  }
  return false;
}
DI void get_fjob(const Params& P, int l, int j, ConvJob& o) {
  char* Bg = P.ws + OFF_BIG;
  if (j == 0) o = ConvJob{P.in[30] + (size_t)l * D * 11264, (bf16_t*)(Bg + B_WFIN), D, 11264, LDW, 1, nullptr};
  else o = ConvJob{P.in[33] + (size_t)l * 5632 * D, (bf16_t*)(Bg + B_WFOUT), 5632, D, LDA2, 0, nullptr};
}
DI void run_conv_item(const Params& P, int lw, int lf, int it, float* sm) {
  ConvJob jb;
  if (lw >= 0) {
    for (int j = 0; j < 14; ++j) {
      if (!get_wjob(P, lw, j, jb)) continue;
      int nt = job_tiles(jb);
      if (it < nt) { run_job_tile(jb, it, sm); return; }
      it -= nt;
    }
  }
  if (lf >= 0) {
    for (int j = 0; j < 2; ++j) {
      get_fjob(P, lf, j, jb);
      int nt = job_tiles(jb);
      if (it < nt) { run_job_tile(jb, it, sm); return; }
      it -= nt;
    }
  }
}
DI int conv_total(int lw, int lf) {
  int n = 0;
  if (lw >= 0) n += 3072 + 3 * 256 + 512 + 96 + 128 + 4 * 16 + 8 + (lw >= 1 ? 16 + 8 : 0);
  if (lf >= 0) n += 32 * 88 + 88 * 16;
  return n;
}

DI void phase_init(const Params& P, char* smem) {
  float* cs = (float*)(P.ws + OFF_SMALL + S_COS);
  float* sn = (float*)(P.ws + OFF_SMALL + S_SIN);
  for (int idx = bidx() * 256 + tidx(); idx < SEQ * 32; idx += gdim() * 256) {
    int t = idx >> 5, d = idx & 31, f = d & 15;
    float inv = powf(10000.f, -(float)f / 16.f);
    float pos = (d < 16) ? (float)(t >> 6) : (float)(t & 63);
    float ang = pos * inv;
    cs[idx] = cosf(ang);
    sn[idx] = sinf(ang);
  }
  float* part = (float*)(P.ws + OFF_OA);
  const int nmod = 2 * 16 * 12;
  const int ntot = nmod + conv_total(0, -1);
  for (int it = bidx(); it < ntot; it += gdim()) {
    if (it < nmod) {
      int l = it / 192, r = it % 192, kc = r / 12, nc = r % 12;
      int n = nc * 1024 + tidx() * 4;
      float4 a0 = {0, 0, 0, 0}, a1 = {0, 0, 0, 0}, a2 = {0, 0, 0, 0};
      const float* w = P.in[4] + (size_t)l * D * INC + n;
      for (int k = kc * 128; k < kc * 128 + 128; ++k) {
        float c0 = P.in[1][k], c1 = P.in[1][D + k], c2 = P.in[3][k];
        c0 = c0 * sigmoidf_(c0); c1 = c1 * sigmoidf_(c1); c2 = c2 * sigmoidf_(c2);
        float4 wv = *(const float4*)(w + (size_t)k * INC);
        a0.x += c0 * wv.x; a0.y += c0 * wv.y; a0.z += c0 * wv.z; a0.w += c0 * wv.w;
        a1.x += c1 * wv.x; a1.y += c1 * wv.y; a1.z += c1 * wv.z; a1.w += c1 * wv.w;
        a2.x += c2 * wv.x; a2.y += c2 * wv.y; a2.z += c2 * wv.z; a2.w += c2 * wv.w;
      }
      float* pp = part + ((size_t)(l * 16 + kc) * 3) * INC + n;
      *(float4*)(pp) = a0;
      *(float4*)(pp + INC) = a1;
      *(float4*)(pp + 2 * INC) = a2;
    } else {
      run_conv_item(P, 0, -1, it - nmod, (float*)smem);
    }
  }
}

DI void phase_modred(const Params& P) {
  const float* part = (const float*)(P.ws + OFF_OA);
  float* mod = (float*)(P.ws + OFF_SMALL + S_MOD);
  for (int idx = bidx() * 256 + tidx(); idx < 2 * 3 * INC; idx += gdim() * 256) {
    int l = idx / (3 * INC), r = idx % (3 * INC), j = r / INC, n = r % INC;
    float a = P.in[5][l * INC + n];
    for (int kc = 0; kc < 16; ++kc) a += part[((size_t)(l * 16 + kc) * 3 + j) * INC + n];
    mod[idx] = a;
  }
}

DI void phase_norm(const Params& P, int l, int which) {
  const int lane = tidx() & 63, wid = tidx() >> 6;
  bf16_t* H = (bf16_t*)(P.ws + OFF_H);
  const float* g = (which == 1 ? P.in[6] : P.in[29]) + l * D;
  if (which == 1) {
    float* ssq = (float*)(P.ws + OFF_SMALL + S_SSQ);
    for (int idx = bidx() * 256 + tidx(); idx < T * 2; idx += gdim() * 256) ssq[idx] = 0.f;
  }
  for (int row = bidx() * 4 + wid; row < T; row += gdim() * 4) {
    const int b = row / SB, s = row - b * SB;
    const float* xr = (which == 1 && l == 0) ? xrow_in(P, row) : xrow(P, row);
    const float* sh = modvec(P, l, b, s, which == 1 ? 0 : 3);
    const float* sc = modvec(P, l, b, s, which == 1 ? 1 : 4);
    float4 v[8];
    float ss = 0.f;
#pragma unroll
    for (int i = 0; i < 8; ++i) {
      v[i] = *(const float4*)(xr + lane * 4 + i * 256);
      ss += v[i].x * v[i].x + v[i].y * v[i].y + v[i].z * v[i].z + v[i].w * v[i].w;
    }
    ss = wave_sum(ss);
    const float rs = rsqrtf(ss * (1.f / 2048.f) + 1e-6f);
#pragma unroll
    for (int i = 0; i < 8; ++i) {
      const int c = lane * 4 + i * 256;
      float4 gg = *(const float4*)(g + c), s4 = *(const float4*)(sh + c), c4 = *(const float4*)(sc + c);
      float o0 = v[i].x * rs * gg.x * (1.f + c4.x) + s4.x;
      float o1 = v[i].y * rs * gg.y * (1.f + c4.y) + s4.y;
      float o2 = v[i].z * rs * gg.z * (1.f + c4.z) + s4.z;
      float o3 = v[i].w * rs * gg.w * (1.f + c4.w) + s4.w;
      *(uint2*)(H + (size_t)row * LDH + c) = uint2{pack2(o0, o1), pack2(o2, o3)};
    }
  }
}

DI void phase_final(const Params& P) {
  const int lane = tidx() & 63, wid = tidx() >> 6;
  const float* g = P.in[34];
  for (int r = bidx() * 4 + wid; r < 2 * SEQ; r += gdim() * 4) {
    float* xr = P.out + (size_t)r * D;
    float4 v[8];
    float ss = 0.f;
#pragma unroll
    for (int i = 0; i < 8; ++i) {
      v[i] = *(const float4*)(xr + lane * 4 + i * 256);
      ss += v[i].x * v[i].x + v[i].y * v[i].y + v[i].z * v[i].z + v[i].w * v[i].w;
    }
    ss = wave_sum(ss);
    const float rs = rsqrtf(ss * (1.f / 2048.f) + 1e-6f);
#pragma unroll
    for (int i = 0; i < 8; ++i) {
      const int c = lane * 4 + i * 256;
      float4 gg = *(const float4*)(g + c);
      *(float4*)(xr + c) = float4{v[i].x * rs * gg.x, v[i].y * rs * gg.y, v[i].z * rs * gg.z, v[i].w * rs * gg.w};
    }
  }
}

template <class Epi>
DI void gemm_item_plain(const bf16_t* A, int lda, const bf16_t* Bt, int ldb, int K, int ntn, char* smem, const Epi& epi, int it) {
  int mt = it / ntn, nt = it - mt * ntn;
  int b = mt / 130, s0 = (mt - b * 130) * 128;
  gemm_tile(A, lda, Bt, ldb, K, b, s0, nt * 128, smem, epi);
}
template <class Epi>
DI void gemm_phase_plain(const bf16_t* A, int lda, const bf16_t* Bt, int ldb, int K, int ntn, char* smem, const Epi& epi) {
  const int total = 260 * ntn;
  for (int it = bidx(); it < total; it += gdim()) gemm_item_plain(A, lda, Bt, ldb, K, ntn, smem, epi, it);
}
template <class Epi>
DI void gemm_phase_overlap(const bf16_t* A, int lda, const bf16_t* Bt, int ldb, int K, int ntn, char* smem, const Epi& epi) {
  const int total = 266 * ntn;
  for (int it = bidx(); it < total; it += gdim()) {
    int mt = it / ntn, nt = it - mt * ntn;
    int b = mt / 133, s0 = (mt - b * 133) * 126 - 1;
    gemm_tile(A, lda, Bt, ldb, K, b, s0, nt * 128, smem, epi);
  }
}

DI void phase_lora(const Params& P, int l, char* smem) {
  char* W = P.ws + OFF_W; char* Bg = P.ws + OFF_BIG;
  const bf16_t* lora = (const bf16_t*)(Bg + B_LORA);
  if (bidx() == 0) {
    int* cnt = (int*)(P.ws + OFF_SMALL + S_CNT);
    for (int i = tidx(); i < 4096 + 64; i += 256) cnt[i] = 0;
  }
  const int per = 260 * 8;
  const int total = 5 * per + (l >= 1 ? 260 : 0);
  for (int it = bidx(); it < total; it += gdim()) {
    int j = it / per, r = it - j * per;
    if (j < 2) {
      EpiDecay e{P.in[9] + (size_t)(l * 2 + j) * 1024, (bf16_t*)(Bg + (j == 0 ? B_EF : B_EB))};
      gemm_item_plain(lora + j * 128, 576, (const bf16_t*)(W + W_W2) + (size_t)j * 1024 * 128, 128, 128, 8, smem, e, r);
    } else if (j < 4) {
      EpiSigBias e{P.in[11] + (size_t)(l * 2 + (j - 2)) * 1024, (bf16_t*)(Bg + (j == 2 ? B_AF : B_AB)), 1024};
      gemm_item_plain(lora + j * 128, 576, (const bf16_t*)(W + W_A2) + (size_t)(j - 2) * 1024 * 128, 128, 128, 8, smem, e, r);
    } else if (j == 4) {
      EpiStore e{(bf16_t*)(P.ws + OFF_OA), 1024, 1024};
      gemm_item_plain(lora + 512, 576, (const bf16_t*)(W + W_G2), 64, 64, 8, smem, e, r);
    } else {
      EpiStore e{(bf16_t*)(P.ws + OFF_SMALL + S_TV1), 64, 64};
      gemm_item_plain((const bf16_t*)(Bg + B_ZRKV) + 2048, 3072, (const bf16_t*)(W + W_V1), 1024, 1024, 1, smem, e, r);
    }
  }
}

DI void scan_load(u32x2 (&raw)[5], const bf16_t* R, const bf16_t* E, const bf16_t* Aa, int b, int dir, int i, int k4) {
  int s = dir == 0 ? i : (i < 256 ? 255 - i : 16895 - i);
  size_t row = (size_t)b * SB + s;
  raw[0] = gload8(R + row * 3072 + k4);
  raw[1] = gload8(R + row * 3072 + 1024 + k4);
  raw[2] = gload8(R + row * 3072 + 2048 + k4);
  raw[3] = gload8(E + row * 1024 + k4);
  raw[4] = gload8(Aa + row * 1024 + k4);
}
DI void scan_prep(u32x2 (&raw)[5], const float (&kkw)[4], const float (&kaw)[4], float* dst  ) {
  vm_wait5x2(raw[0], raw[1], raw[2], raw[3], raw[4]);
  float r[4] = {bflo(raw[0].x), bfhi(raw[0].x), bflo(raw[0].y), bfhi(raw[0].y)};
  float k[4] = {bflo(raw[1].x), bfhi(raw[1].x), bflo(raw[1].y), bfhi(raw[1].y)};
  float v[4] = {bflo(raw[2].x), bfhi(raw[2].x), bflo(raw[2].y), bfhi(raw[2].y)};
  float e[4] = {bflo(raw[3].x), bfhi(raw[3].x), bflo(raw[3].y), bfhi(raw[3].y)};
  float a[4] = {bflo(raw[4].x), bfhi(raw[4].x), bflo(raw[4].y), bfhi(raw[4].y)};
  float kr[4], ss = 0.f;
#pragma unroll
  for (int i = 0; i < 4; ++i) { kr[i] = mul_(k[i], kkw[i]); ss = (i < 3) ? fma_(kr[i], kr[i], ss) : fma_n_(kr[i], kr[i], ss); }
  ss = reduce16(ss);
  const float inv = __builtin_amdgcn_rcpf(fmaxf(__builtin_amdgcn_sqrtf(ss), 1e-12f));
  float w4[4], kd4[4], a4[4], b4[4];
#pragma unroll
  for (int i = 0; i < 4; ++i) {
    float kn = kr[i] * inv;
    w4[i] = __builtin_amdgcn_exp2f(mul_(e[i], -LOG2E));
    kd4[i] = mul_(k[i], fma_(add_(a[i], -1.f), kaw[i], 1.f));
    a4[i] = -kn;
    b4[i] = mul_(kn, a[i]);
  }
  *(float4*)(dst) = float4{r[0], r[1], r[2], r[3]};
  *(float4*)(dst + 64) = float4{w4[0], w4[1], w4[2], w4[3]};
  *(float4*)(dst + 128) = float4{kd4[0], kd4[1], kd4[2], kd4[3]};
  *(float4*)(dst + 192) = float4{a4[0], a4[1], a4[2], a4[3]};
  *(float4*)(dst + 256) = float4{b4[0], b4[1], b4[2], b4[3]};
  *(float4*)(dst + 320) = float4{v[0], v[1], v[2], v[3]};
}

DI void phase_scan(const Params& P, int l, char* smem) {
  char* Bg = P.ws + OFF_BIG;
  const int tid = tidx();
  const int st = tid >> 4, kl = tid & 15, k4 = kl * 4;
  float* buf = (float*)smem;
  for (int item = bidx(); item < 256; item += gdim()) {
    const int inst = item >> 2, vb = item & 3;
    const int b = inst >> 5, h = (inst >> 1) & 15, dir = inst & 1;
    const bf16_t* R = (const bf16_t*)(Bg + B_ZRKV) + h * 64;
    const bf16_t* E = (const bf16_t*)(Bg + (dir ? B_EB : B_EF)) + h * 64;
    const bf16_t* Aa = (const bf16_t*)(Bg + (dir ? B_AB : B_AF)) + h * 64;
    bf16_t* Y = (bf16_t*)(P.ws + (dir ? OFF_OC : OFF_OB)) + h * 64 + vb * 16;
    float kkw[4], kaw[4];
#pragma unroll
    for (int i = 0; i < 4; ++i) {
      kkw[i] = P.in[14][l * 1024 + h * 64 + k4 + i];
      kaw[i] = P.in[15][l * 1024 + h * 64 + k4 + i];
    }
    float S0 = 0.f, S1 = 0.f, S2 = 0.f, S3 = 0.f;
    u32x2 raw[5];
    scan_load(raw, R, E, Aa, b, dir, st, k4);
    scan_prep(raw, kkw, kaw, buf + st * 384 + k4);
    __syncthreads();
    const int nchunk = SB / 16;
    for (int c = 0; c < nchunk; ++c) {
      if (c + 1 < nchunk) scan_load(raw, R, E, Aa, b, dir, (c + 1) * 16 + st, k4);
      cfence();
      const float* cb = buf + (c & 1) * (16 * 384);
      float ykeep = 0.f;
#define SCAN_LOAD(SET, G)                                                          \
  _Pragma("unroll") for (int q_ = 0; q_ < 4; ++q_) {                                \
    const float* sb_ = cb + ((G) * 4 + q_) * 384;                                   \
    SET##r[q_] = *(const float4*)(sb_ + k4);                                        \
    SET##w[q_] = *(const float4*)(sb_ + 64 + k4);                                   \
    SET##k[q_] = *(const float4*)(sb_ + 128 + k4);                                  \
    SET##a[q_] = *(const float4*)(sb_ + 192 + k4);                                  \
    SET##b[q_] = *(const float4*)(sb_ + 256 + k4);                                  \
    SET##v[q_] = sb_[320 + vb * 16 + st];                                           \
  }
#define SCAN_STEPS(SET, G)                                                         \
  _Pragma("unroll") for (int q_ = 0; q_ < 4; ++q_) {                                \
    const float4 r4 = SET##r[q_], w4 = SET##w[q_], kd = SET##k[q_], a4 = SET##a[q_], b4 = SET##b[q_]; \
    const float vv = SET##v[q_];                                                    \
    float sa = fma_n_(S3, a4.w, fma_(S2, a4.z, fma_(S1, a4.y, mul_(S0, a4.x)))); \
    const float z0 = fma_(S0, w4.x, mul_(vv, kd.x)), z1 = fma_(S1, w4.y, mul_(vv, kd.y)); \
    const float z2 = fma_(S2, w4.z, mul_(vv, kd.z)), z3 = fma_(S3, w4.w, mul_(vv, kd.w)); \
    sa = reduce16(sa);                                                              \
    S0 = fma_(sa, b4.x, z0);                                                        \
    S1 = fma_(sa, b4.y, z1);                                                        \
    S2 = fma_(sa, b4.z, z2);                                                        \
    S3 = fma_(sa, b4.w, z3);                                                        \
    float y = fma_n_(S3, r4.w, fma_(S2, r4.z, fma_(S1, r4.y, mul_(S0, r4.x)))); \
    y = reduce16(y);                                                                \
    ykeep = sel_mask_(ykeep, y, 0x0001000100010001ull << ((G) * 4 + q_));            \
  }
      {
        float4 Ar[4], Aw[4], Ak[4], Aa[4], Ab[4], Br[4], Bw[4], Bk[4], Ba[4], Bb[4];
        float Av[4], Bv[4];
        SCAN_LOAD(A, 0);
        SCAN_LOAD(B, 1);
        SCAN_STEPS(A, 0);
        SCAN_LOAD(A, 2);
        SCAN_STEPS(B, 1);
        SCAN_LOAD(B, 3);
        SCAN_STEPS(A, 2);
        SCAN_STEPS(B, 3);
      }
#undef SCAN_LOAD
#undef SCAN_STEPS
      {
        int i = c * 16 + kl;
        int s = dir == 0 ? i : (i < 256 ? 255 - i : 16895 - i);
        Y[((size_t)b * SB + s) * 1024 + st] = f2bf(ykeep);
      }
      if (c + 1 < nchunk) scan_prep(raw, kkw, kaw, buf + ((c + 1) & 1) * (16 * 384) + st * 384 + k4);
      __syncthreads();
    }
  }
}

DI void phase_post(const Params& P, int l) {
  char* Bg = P.ws + OFF_BIG;
  const bf16_t* Z = (const bf16_t*)(Bg + B_ZRKV);
  const bf16_t* AF = (const bf16_t*)(Bg + B_AF);
  const bf16_t* AB = (const bf16_t*)(Bg + B_AB);
  const bf16_t* YF = (const bf16_t*)(P.ws + OFF_OB);
  const bf16_t* YB = (const bf16_t*)(P.ws + OFF_OC);
  bf16_t* OA = (bf16_t*)(P.ws + OFF_OA);
  const int kl = tidx() & 15;
  const int ngroups = T * 16;
  for (int gidx = bidx() * 16 + (tidx() >> 4); gidx < ngroups; gidx += gdim() * 16) {
    const int row = gidx >> 4, h = gidx & 15;
    const int c = h * 64 + kl * 4;
    uint2 uyf = *(const uint2*)(YF + (size_t)row * 1024 + c), uyb = *(const uint2*)(YB + (size_t)row * 1024 + c);
    float y[4] = {bflo(uyf.x) + bflo(uyb.x), bfhi(uyf.x) + bfhi(uyb.x), bflo(uyf.y) + bflo(uyb.y), bfhi(uyf.y) + bfhi(uyb.y)};
    float mean = reduce16(y[0] + y[1] + y[2] + y[3]) * (1.f / 64.f);
    float dd[4] = {y[0] - mean, y[1] - mean, y[2] - mean, y[3] - mean};
    float var = reduce16(dd[0] * dd[0] + dd[1] * dd[1] + dd[2] * dd[2] + dd[3] * dd[3]) * (1.f / 64.f);
    float rstd = rsqrtf(var + 64e-5f);
    uint2 ur = *(const uint2*)(Z + (size_t)row * 3072 + c), uk = *(const uint2*)(Z + (size_t)row * 3072 + 1024 + c),
          uv = *(const uint2*)(Z + (size_t)row * 3072 + 2048 + c);
    uint2 uaf = *(const uint2*)(AF + (size_t)row * 1024 + c), uab = *(const uint2*)(AB + (size_t)row * 1024 + c);
    uint2 ug = *(const uint2*)(OA + (size_t)row * 1024 + c);
    float r[4] = {bflo(ur.x), bfhi(ur.x), bflo(ur.y), bfhi(ur.y)};
    float k[4] = {bflo(uk.x), bfhi(uk.x), bflo(uk.y), bfhi(uk.y)};
    float v[4] = {bflo(uv.x), bfhi(uv.x), bflo(uv.y), bfhi(uv.y)};
    float af[4] = {bflo(uaf.x), bfhi(uaf.x), bflo(uaf.y), bfhi(uaf.y)};
    float ab[4] = {bflo(uab.x), bfhi(uab.x), bflo(uab.y), bfhi(uab.y)};
    float g[4] = {bflo(ug.x), bfhi(ug.x), bflo(ug.y), bfhi(ug.y)};
    float bon = 0.f;
#pragma unroll
    for (int i = 0; i < 4; ++i) {
      float ka = P.in[15][l * 1024 + c + i];
      float ksum = k[i] * (2.f + (af[i] + ab[i] - 2.f) * ka);
      bon += r[i] * ksum * P.in[16][l * 1024 + c + i];
    }
    bon = reduce16(bon);
    float o[4];
#pragma unroll
    for (int i = 0; i < 4; ++i) {
      float yn = dd[i] * rstd * P.in[17][l * 1024 + c + i] + P.in[18][l * 1024 + c + i];
      o[i] = (yn + bon * v[i]) * g[i];
    }
    *(uint2*)(OA + (size_t)row * 1024 + c) = uint2{pack2(o[0], o[1]), pack2(o[2], o[3])};
  }
}

DI int vswz(int d) { const int g = (d >> 2) & 7; return (g ^ ((g >> 2) * 3)) & 3; }
template <int DQK, int DV>
struct AttnMap {
  unsigned koff[DQK / 64], kl[DQK / 64];
  unsigned voff[DV / 64], vl0[DV / 64], vl1[DV / 64];
  DI void init(int ldk) {
    const int tid = tidx();
    constexpr int CPR = DQK / 8;
#pragma unroll
    for (int j = 0; j < DQK / 64; ++j) {
      int c = tid + 256 * j, row = c / CPR, kc = c - row * CPR;
      int pc = (kc & ~7) | ((kc & 7) ^ ((row >> 1) & 7));
      koff[j] = (unsigned)(row * ldk + kc * 8) * 2u;
      kl[j] = (unsigned)(row * (DQK * 2) + pc * 16);
    }
#pragma unroll
    for (int j = 0; j < DV / 64; ++j) {
      int c = tid + 256 * j, d = c >> 2, part = c & 3, f = vswz(d);
      voff[j] = (unsigned)(d * SB + part * 8) * 2u;
      vl0[j] = (unsigned)(d * 64 + (((2 * (part >> 1)) ^ f) << 4) + (part & 1) * 8);
      vl1[j] = (unsigned)(d * 64 + (((2 * (part >> 1) + 1) ^ f) << 4) + (part & 1) * 8);
    }
  }
};
template <int DQK, int DV>
DI void attn_load(u32x4 (&rk)[DQK / 64], u32x4 (&rv)[DV / 64], const AttnMap<DQK, DV>& mp, brsrc_t Kr, int ldk, brsrc_t Vr, int key0) {
  const unsigned ks = (unsigned)key0 * (unsigned)(ldk * 2), vs = (unsigned)key0 * 2u;
#pragma unroll
  for (int j = 0; j < DQK / 64; ++j) rk[j] = bload16(Kr, mp.koff[j], ks);
#pragma unroll
  for (int j = 0; j < DV / 64; ++j) rv[j] = bload16(Vr, mp.voff[j], vs);
}
template <int DQK, int DV>
DI void attn_store(u32x4 (&rk)[DQK / 64], u32x4 (&rv)[DV / 64], const AttnMap<DQK, DV>& mp, char* sK, char* sV) {
#pragma unroll
  for (int j = 0; j < DQK / 64; ++j) *(u32x4*)(sK + mp.kl[j]) = rk[j];
#pragma unroll
  for (int j = 0; j < DV / 64; ++j) {
    *(uint2*)(sV + mp.vl0[j]) = uint2{rv[j].x, rv[j].y};
    *(uint2*)(sV + mp.vl1[j]) = uint2{rv[j].z, rv[j].w};
  }
}

template <int DQK, int DV>
DI void attn_tile(const bf16_t* Q, int ldq, const bf16_t* Kb, int ldk, const bf16_t* Vt, bf16_t* O, int ldo, int b, int sq0,
                  int r0a, int r0b, int r1a, int r1b, float m_init, float l_init, char* smem) {
  const int tid = tidx(), lane = tid & 63, wid = tid >> 6;
  const int ql = lane & 31, hh = lane >> 5;
  constexpr int NS = DQK / 16, NB = DV / 32;
  constexpr int KB = 32 * DQK * 2, VB = DV * 64, BUF = KB + VB;
  const int qs = sq0 + wid * 32 + ql;
  bf16x8 qf[NS];
  {
    const bf16_t* qp = Q + (size_t)(b * SB + qs) * ldq + 8 * hh;
#pragma unroll
    for (int s = 0; s < NS; ++s) qf[s] = *(const bf16x8*)(qp + 16 * s);
  }
  f32x16 acc[NB];
#pragma unroll
  for (int i = 0; i < NB; ++i)
#pragma unroll
    for (int r = 0; r < 16; ++r) acc[i][r] = 0.f;
  float m = m_init, lsum = l_init;
  const int n0 = (r0b - r0a) >> 5, n1 = (r1b > r1a) ? ((r1b - r1a) >> 5) : 0;
  const int nt = n0 + n1;
  const brsrc_t Kbase = make_rsrc(Kb + (size_t)b * SB * ldk);
  const brsrc_t Vbase = make_rsrc(Vt);
  AttnMap<DQK, DV> mp;
  mp.init(ldk);
  u32x4 rk[DQK / 64], rv[DV / 64];
  attn_load<DQK, DV>(rk, rv, mp, Kbase, ldk, Vbase, r0a);
  attn_store<DQK, DV>(rk, rv, mp, smem, smem + KB);
  __syncthreads();
  for (int it = 0; it < nt; ++it) {
    const int key0 = it < n0 ? r0a + 32 * it : r1a + 32 * (it - n0);
    const bool masked = it >= n0;
    {
      const int itn = (it + 1 < nt) ? it + 1 : it;
      const int nk0 = itn < n0 ? r0a + 32 * itn : r1a + 32 * (itn - n0);
      attn_load<DQK, DV>(rk, rv, mp, Kbase, ldk, Vbase, nk0);
    }
    cfence();
    const char* sK = smem + (it & 1) * BUF;
    const char* sV = sK + KB;
    f32x16 S;
#pragma unroll
    for (int r = 0; r < 16; ++r) S[r] = 0.f;
    {
      const char* kr = sK + ql * (DQK * 2);
      const int f = (ql >> 1) & 7;
#pragma unroll
      for (int s = 0; s < NS; ++s) {
        const int c = 2 * s + hh;
        const int pc = (c & ~7) | ((c & 7) ^ f);
        bf16x8 kf = *(const bf16x8*)(kr + pc * 16);
        S = MFMA32(kf, qf[s], S);
      }
    }
    if (masked) {
#pragma unroll
      for (int r = 0; r < 16; ++r) {
        int ks = key0 + (r & 3) + 8 * (r >> 2) + 4 * hh;
        int df = ks - qs;
        if (df > 128 || df < -128) S[r] = -1e30f;
      }
    }
    float mx = S[0];
#pragma unroll
    for (int r = 1; r < 16; ++r) mx = fmaxf(mx, S[r]);
    mx = xhalf_max(mx);
    const float mn = fmaxf(m, mx);
    const float alpha = __builtin_amdgcn_exp2f(m - mn);
    m = mn;
    float p[16], rsum = 0.f;
#pragma unroll
    for (int r = 0; r < 16; ++r) { p[r] = __builtin_amdgcn_exp2f(S[r] - mn); rsum += p[r]; }
    rsum = xhalf_sum(rsum);
    lsum = lsum * alpha + rsum;
    if (__any(alpha != 1.f)) {
#pragma unroll
      for (int i = 0; i < NB; ++i)
#pragma unroll
        for (int r = 0; r < 16; ++r) acc[i][r] *= alpha;
    }
    bf16x8 pf[2];
#pragma unroll
    for (int s2 = 0; s2 < 2; ++s2) {
      unsigned w0 = pack2(p[8 * s2 + 0], p[8 * s2 + 1]), w1 = pack2(p[8 * s2 + 2], p[8 * s2 + 3]);
      unsigned w2 = pack2(p[8 * s2 + 4], p[8 * s2 + 5]), w3 = pack2(p[8 * s2 + 6], p[8 * s2 + 7]);
      uint4 u = {w0, w1, w2, w3};
      pf[s2] = __builtin_bit_cast(bf16x8, u);
    }
#pragma unroll
    for (int i = 0; i < NB; ++i) {
      const int d = i * 32 + ql, f = vswz(d);
      const char* vr = sV + d * 64;
#pragma unroll
      for (int s2 = 0; s2 < 2; ++s2) {
        bf16x8 vf = *(const bf16x8*)(vr + (((2 * s2 + hh) ^ f) << 4));
        acc[i] = MFMA32(vf, pf[s2], acc[i]);
      }
    }
    {
      char* dK = smem + ((it + 1) & 1) * BUF;
      attn_store<DQK, DV>(rk, rv, mp, dK, dK + KB);
    }
    __syncthreads();
  }
  const float inv = 1.f / lsum;
  bf16_t* op = O + (size_t)(b * SB + qs) * ldo;
#pragma unroll
  for (int i = 0; i < NB; ++i)
#pragma unroll
    for (int g = 0; g < 4; ++g) {
      uint2 u = {pack2(acc[i][4 * g] * inv, acc[i][4 * g + 1] * inv), pack2(acc[i][4 * g + 2] * inv, acc[i][4 * g + 3] * inv)};
      *(uint2*)(op + i * 32 + 8 * g + 4 * hh) = u;
    }
}

DI void phase_attn(const Params& P, int l, char* smem) {
  char* Bg = P.ws + OFF_BIG;
  const int nmla_l = 2048, nmla_c = 32, nwa = 2 * 16 * 130;
  const int total = nmla_l + nmla_c + nwa;
  for (int it = bidx(); it < total; it += gdim()) {
    if (l == 1) {
      if (it >= nmla_l && it < nmla_l + nmla_c) continue;
      if (it >= nmla_l + nmla_c && ((it - nmla_l - nmla_c) % 130) < 2) continue;
    }
    if (it < nmla_l + nmla_c) {
      int b, h, sq0, kend;
      if (it < nmla_l) {
        const int j = (it & 7) * (nmla_l >> 3) + (it >> 3);
        int bh = j >> 7, qt = j & 127; b = bh >> 3; h = bh & 7; sq0 = CTXL + 128 * qt; kend = SB;
      }
      else { int i2 = it - nmla_l; int bh = i2 >> 1, qt = i2 & 1; b = bh >> 3; h = bh & 7; sq0 = 128 * qt; kend = CTXL; }
      attn_tile<192, 128>((const bf16_t*)(Bg + B_QMLA) + h * 192, LDKQ, (const bf16_t*)(Bg + B_KMLA) + h * 192, LDKQ,
                          (const bf16_t*)(Bg + B_VTMLA) + ((size_t)b * 1024 + h * 128) * SB, (bf16_t*)(P.ws + OFF_OC) + h * 128, 1024,
                          b, sq0, 0, kend, 0, 0, -1e30f, 0.f, smem);
    } else {
      int i2 = it - nmla_l - nmla_c;
      int bh = i2 / 130, qt = i2 - bh * 130;
      int b = bh >> 4, h = bh & 15, kvh = h >> 2;
      int sq0 = 128 * qt;
      int r1a = 0, r1b = 0;
      if (qt >= 2) {
        r1a = sq0 - 128; if (r1a < CTXL) r1a = CTXL;
        r1b = sq0 + 256; if (r1b > SB) r1b = SB;
      }
      float sink = P.in[22][l * 16 + h] * LOG2E;
      attn_tile<64, 64>((const bf16_t*)(Bg + B_QWA) + h * 64, 1024, (const bf16_t*)(Bg + B_KWA) + kvh * 64, 256,
                        (const bf16_t*)(Bg + B_VTWA) + ((size_t)b * 256 + kvh * 64) * SB, (bf16_t*)(P.ws + OFF_OB) + h * 64, 1024,
                        b, sq0, 0, CTXL, r1a, r1b, sink, 1.f, smem);
    }
  }
}

DI void phase_inproj_att(const Params& P, int l, char* smem) {
  char* W = P.ws + OFF_W; char* Bg = P.ws + OFF_BIG;
  const bf16_t* H = (const bf16_t*)(P.ws + OFF_H);
  const float* cs = (const float*)(P.ws + OFF_SMALL + S_COS);
  const float* sn = (const float*)(P.ws + OFF_SMALL + S_SIN);
  const int nwa = 130 * 12, nml = 130 * 9;
  for (int it = bidx(); it < nwa + nml; it += gdim()) {
    if (it < nwa) {
      EpiWA e{(bf16_t*)(Bg + B_QWA), (bf16_t*)(Bg + B_KWA), (bf16_t*)(Bg + B_VTWA), cs, sn};
      gemm256_item_plain(H, LDH, (const bf16_t*)(W + W_IN) + (size_t)3520 * LDW, LDW, D, 12, smem, e, it);
    } else {
      EpiMLAin e{(bf16_t*)(Bg + B_ZMLA), (float*)(P.ws + OFF_SMALL + S_SSQ)};
      gemm256_item_plain(H, LDH, (const bf16_t*)(W + W_IN) + (size_t)5056 * LDW, LDW, D, 9, smem, e, it - nwa);
    }
  }
}

DI void phase_uproj(const Params& P, int l, char* smem) {
  char* W = P.ws + OFF_W; char* Bg = P.ws + OFF_BIG;
  const bf16_t* Z = (const bf16_t*)(Bg + B_ZMLA);
  const float* cs = (const float*)(P.ws + OFF_SMALL + S_COS);
  const float* sn = (const float*)(P.ws + OFF_SMALL + S_SIN);
  const float* ssq = (const float*)(P.ws + OFF_SMALL + S_SSQ);
  bf16_t* Kd = (bf16_t*)(Bg + B_KMLA);
  for (int idx = bidx() * 256 + tidx(); idx < T * 32; idx += gdim() * 256) {
    int row = idx >> 5, d = idx & 31;
    int b = row / SB, s = row - b * SB;
    float a = bf2f(Z[(size_t)row * 1088 + 1024 + d]), bb = bf2f(Z[(size_t)row * 1088 + 1024 + d + 32]);
    if (s >= CTXL) rope_pair(a, bb, cs, sn, s - CTXL, d);
    bf16_t ua = f2bf(a), ub = f2bf(bb);
#pragma unroll
    for (int h = 0; h < 8; ++h) {
      Kd[(size_t)row * LDKQ + h * 192 + 128 + d] = ua;
      Kd[(size_t)row * LDKQ + h * 192 + 160 + d] = ub;
    }
  }
  const int nq = 130 * 12, nkv = 130 * 16;
  for (int it = bidx(); it < nq + nkv; it += gdim()) {
    if (it < nq) {
      EpiUQ e{(bf16_t*)(Bg + B_QMLA), ssq, cs, sn};
      gemm256_item_plain(Z, 1088, (const bf16_t*)(W + W_UQ), LDUQ, 512, 12, smem, e, it);
    } else {
      EpiUKV e{Kd, (bf16_t*)(Bg + B_VTMLA), ssq};
      gemm256_item_plain(Z + 512, 1088, (const bf16_t*)(W + W_UKV), LDUQ, 512, 16, smem, e, it - nq);
    }
  }
}

DI void phase_merge(const Params& P, char* smem, bool skip_ctx) {
  char* W = P.ws + OFF_W;
  const bf16_t* G = (const bf16_t*)(P.ws + OFF_BIG + B_G);
  bf16_t* Y = (bf16_t*)(P.ws + OFF_H);
  const int tid = tidx(), lane = tid & 63, wid = tid >> 6;
  const int wr = wid >> 1, wc = wid & 1, fr = lane & 15, fq = lane >> 4;
  const int total = 260 * 16;
  for (int it = bidx(); it < total; it += gdim()) {
    int mt = it >> 4, nt = it & 15;
    int b = mt / 130, s0 = (mt - b * 130) * 128, col0 = nt * 128;
    if (skip_ctx && s0 < CTXL) continue;
    f32x4 yacc[4][4];
    zero_acc(yacc);
#pragma unroll 1
    for (int i = 0; i < 3; ++i) {
      f32x4 acc[4][4];
      zero_acc(acc);
      const bf16_t* Oi = (const bf16_t*)(P.ws + (i == 0 ? OFF_OA : (i == 1 ? OFF_OB : OFF_OC)));
      gemm_kloop1(acc, Oi, 1024, (const bf16_t*)(W + W_BR) + (size_t)i * D * LDWB, LDWB, 1024, b, s0, col0, smem);
#pragma unroll
      for (int m = 0; m < 4; ++m)
#pragma unroll
        for (int n = 0; n < 4; ++n)
#pragma unroll
          for (int j = 0; j < 4; ++j) {
            size_t row = (size_t)b * SB + s0 + wr * 64 + m * 16 + fq * 4 + j;
            float gv = bf2f(G[row * 6144 + i * 2048 + col0 + wc * 64 + n * 16 + fr]);
            yacc[m][n][j] += gv * acc[m][n][j];
          }
    }
    float* tile = (float*)smem;
    acc_to_tile(yacc, tile);
    __syncthreads();
    EpiStore e{Y, LDH, D};
    e(tile, b, s0, col0);
    __syncthreads();
  }
}

constexpr int NPHASE = 33;
#ifndef PH_MASK
#define PH_MASK 0xFFFFFFFFu
#endif
#define PH_ON(n) ((PH_MASK >> (n)) & 1u)
DI bool phase_empty(int ph) { return ph == 2 + 3; }

DI void run_phase(const Params& P, int ph, char* smem) {
  if (ph == 0) { if (PH_ON(15)) phase_init(P, smem); return; }
  if (ph == 1) { if (PH_ON(16)) phase_modred(P); return; }
  if (ph == 32) { if (PH_ON(17)) phase_final(P); return; }
  const int l = (ph - 2) / 15, q = (ph - 2) % 15;
  char* W = P.ws + OFF_W; char* Bg = P.ws + OFF_BIG;
  const bf16_t* H = (const bf16_t*)(P.ws + OFF_H);
  switch (q) {
    case 0: if (PH_ON(0)) phase_norm(P, l, 1); break;
    case 1: if (PH_ON(1)) {
      EpiRW e{P.in[8] + (size_t)l * 3520, (bf16_t*)(Bg + B_ZRKV), (bf16_t*)(Bg + B_LORA), l == 0 ? (bf16_t*)(P.ws + OFF_VF) : nullptr};
      gemm256_phase_overlap(H, LDH, (const bf16_t*)(W + W_IN), LDW, D, 28, smem, e);
    } break;
    case 2: if (PH_ON(2)) phase_lora(P, l, smem); break;
    case 3: if (PH_ON(3)) {
      if (l >= 1) {
        EpiVres e{P.in[19] + (size_t)(l - 1) * 1024, (bf16_t*)(Bg + B_ZRKV), (const bf16_t*)(P.ws + OFF_VF)};
        gemm_phase_plain((const bf16_t*)(P.ws + OFF_SMALL + S_TV1), 64, (const bf16_t*)(W + W_V2), 64, 64, 8, smem, e);
      }
    } break;
    case 4: if (PH_ON(4)) phase_scan(P, l, smem); break;
    case 5: if (PH_ON(5)) phase_post(P, l); break;
    case 6: if (PH_ON(6)) phase_inproj_att(P, l, smem); break;
    case 7: if (PH_ON(7)) phase_uproj(P, l, smem); break;
    case 8: if (PH_ON(8)) phase_attn(P, l, smem); break;
    case 9: if (PH_ON(9)) {
      EpiSigBias e{nullptr, (bf16_t*)(Bg + B_G), 6144};
      gemm256_phase_plain(H, LDH, (const bf16_t*)(W + W_IN) + (size_t)6144 * LDW, LDW, D, 48, smem, e, l == 1);
    } break;
    case 10: if (PH_ON(10)) phase_merge(P, smem, l == 1); break;
    case 11: if (PH_ON(11)) {
      EpiResid e{&P, l, 2, l == 0};
      gemm256_phase_plain(H, LDH, (const bf16_t*)(W + W_OUT), LDW, D, 16, smem, e, l == 1);
    } break;
    case 12: if (PH_ON(12)) {
      phase_norm(P, l, 2);
      const int lw = (l + 1 < 2) ? l + 1 : -1;
      const int tot = conv_total(lw, l);
      for (int it = bidx(); it < tot; it += gdim()) run_conv_item(P, lw, l, it, (float*)smem);
    } break;
    case 13: if (PH_ON(13)) {
      EpiFFNin e{P.in[31] + (size_t)l * 3 * 5632, P.in[32] + (size_t)l * 5632, (bf16_t*)(Bg + B_A2)};
      gemm256_phase_overlap(H, LDH, (const bf16_t*)(Bg + B_WFIN), LDW, D, 88, smem, e);
    } break;
    case 14: if (PH_ON(14)) {
      EpiResid e{&P, l, 5, false};
      gemm256_phase_plain((const bf16_t*)(Bg + B_A2), LDA2, (const bf16_t*)(Bg + B_WFOUT), LDA2, 5632, 16, smem, e, l == 1);
    } break;
  }
}

__global__ void __launch_bounds__(256, 2) mega(Params P) {
  __shared__ __attribute__((aligned(16))) char smem[69632];
  const int p0 = P.p0, p1 = P.p1;
  for (int ph = p0; ph < p1; ++ph) {
    if (phase_empty(ph)) continue;
    const __attribute__((address_space(4))) char* kp = (const __attribute__((address_space(4))) char*)__builtin_amdgcn_kernarg_segment_ptr();
    asm volatile("" : "+s"(kp));
    const Params& Pr = *(const Params*)(kp);
    int nrep = 1;
#ifdef REP_MASK
    if (ph >= 2 && ph < 32 && ((REP_MASK >> ((ph - 2) % 15)) & 1)) nrep = 2;
#endif
#pragma unroll 1
    for (int rep = 0; rep < nrep; ++rep) run_phase(Pr, ph, smem);
    if (ph + 1 < p1) cg::this_grid().sync();
  }
}

extern "C" void kernel_launch(void* const* d_in, const int* in_sizes, int n_in, void* d_out, int out_size, void* d_ws,
                              size_t ws_size, hipStream_t stream) {
  static int grid_blocks = 0;
  if (!grid_blocks) {
    int dev = 0, cus = 0, per_cu = 0;
    hipGetDevice(&dev);
    hipDeviceGetAttribute(&cus, hipDeviceAttributeMultiprocessorCount, dev);
    hipOccupancyMaxActiveBlocksPerMultiprocessor(&per_cu, mega, 256, 0);
    if (per_cu < 1) per_cu = 1;
    grid_blocks = cus * per_cu;
  }
  Params p;
  memset(&p, 0, sizeof(p));
  for (int i = 0; i < 35; ++i) p.in[i] = (const float*)d_in[i];
  p.out = (float*)d_out;
  p.ws = (char*)d_ws;
#if ONE_LAUNCH
  p.p0 = 0; p.p1 = NPHASE;
  void* args[] = {&p};
  hipError_t e = hipLaunchCooperativeKernel((void*)mega, dim3(grid_blocks), dim3(256), args, 0, stream);
  if (e != hipSuccess) fprintf(stderr, "cooperative launch failed: %s (grid %d)\n", hipGetErrorString(e), grid_blocks);
#else
  for (int ph = 0; ph < NPHASE; ++ph) {
    if (ph == 2 + 3) continue;
    p.p0 = ph; p.p1 = ph + 1;
    hipLaunchKernelGGL(mega, dim3(grid_blocks), dim3(256), 0, stream, p);
  }
#endif
}
```

```cpp
#include <hip/hip_runtime.h>
#include <hip/hip_bf16.h>
#include <hip/hip_cooperative_groups.h>
#include <cstdio>
#include <cstring>
namespace cg = cooperative_groups;

#ifndef ONE_LAUNCH
#define ONE_LAUNCH 1
#endif

typedef unsigned short bf16_t;
using bf16x8 = __attribute__((ext_vector_type(8))) short;
using f32x4 = __attribute__((ext_vector_type(4))) float;
using f32x16 = __attribute__((ext_vector_type(16))) float;
#define DI __device__ __forceinline__

constexpr int D = 2048, SEQ = 16384, CTXL = 256, SB = 16640, T = 33280;
constexpr int INC = 12288;
constexpr size_t MiB = 1u << 20;
constexpr int LDH = 2112, LDW = 2112, LDWB = 1088, LDUQ = 576, LDA2 = 5696, LDKQ = 1600;
constexpr size_t OFF_W = 0, OFF_SMALL = 78 * MiB, OFF_H = 92 * MiB, OFF_VF = 230 * MiB, OFF_OA = 295 * MiB,
                 OFF_OB = 360 * MiB, OFF_OC = 425 * MiB, OFF_BIG = 490 * MiB;
constexpr size_t W_IN = 0, W_BR = W_IN + (size_t)12288 * LDW * 2, W_OUT = W_BR + (size_t)3 * 2048 * LDWB * 2,
                 W_UQ = W_OUT + (size_t)2048 * LDW * 2, W_UKV = W_UQ + (size_t)1536 * LDUQ * 2,
                 W_W2 = W_UKV + (size_t)2048 * LDUQ * 2, W_A2 = W_W2 + 2 * 1024 * 128 * 2, W_G2 = W_A2 + 2 * 1024 * 128 * 2,
                 W_V1 = W_G2 + 1024 * 64 * 2, W_V2 = W_V1 + 128 * 1024 * 2, W_END = W_V2 + 1024 * 64 * 2;
static_assert(W_END <= 78 * MiB, "W region overflow");
static_assert((size_t)T * LDH * 2 <= (230 - 92) * MiB, "H region overflow");
constexpr size_t S_XC = 0, S_MOD = 4 * MiB, S_COS = 5 * MiB, S_SIN = 7 * MiB, S_SSQ = 9 * MiB, S_TV1 = 9 * MiB + 512 * 1024, S_CNT = 13 * MiB + 768 * 1024;
constexpr size_t B_ZRKV = 0, B_LORA = 195 * MiB, B_EF = 232 * MiB, B_EB = 297 * MiB, B_AF = 362 * MiB, B_AB = 427 * MiB;
constexpr size_t B_QWA = 0, B_KWA = 65 * MiB, B_VTWA = 82 * MiB, B_ZMLA = 99 * MiB, B_QMLA = 169 * MiB,
                 B_KMLA = 271 * MiB, B_VTMLA = 373 * MiB;
static_assert((size_t)T * LDKQ * 2 <= 102 * MiB, "q/k mla overflow");
constexpr size_t B_G = 0, B_A2 = 0, B_WFIN = 362 * MiB, B_WFOUT = 408 * MiB;
static_assert((size_t)T * LDA2 * 2 <= 362 * MiB && (size_t)11264 * LDW * 2 <= 46 * MiB && (size_t)2048 * LDA2 * 2 <= 24 * MiB, "ffn stage overflow");

constexpr float LOG2E = 1.4426950408889634f;
extern "C" __device__ size_t __ockl_get_num_groups(unsigned);
DI int tidx() { int t = __builtin_amdgcn_workitem_id_x(); asm volatile("" : "+v"(t)); return t; }
DI int bidx() { int t = __builtin_amdgcn_workgroup_id_x(); asm volatile("" : "+s"(t)); return t; }
DI int gdim() { int t = (int)__ockl_get_num_groups(0); asm volatile("" : "+s"(t)); return t; }


struct Params {
  const float* in[35];
  float* out;
  char* ws;
  int p0, p1;
};

typedef __bf16 hbf16x2_t __attribute__((ext_vector_type(2)));
typedef float hf32x2_t __attribute__((ext_vector_type(2)));
DI unsigned pack2(float a, float b) {
  hf32x2_t v = {a, b};
  return __builtin_bit_cast(unsigned, __builtin_convertvector(v, hbf16x2_t));
}
DI unsigned short f2bf(float x) { return (unsigned short)(pack2(x, 0.f) & 0xffffu); }
DI float bf2f(unsigned short h) { return __uint_as_float(((unsigned)h) << 16); }
DI float bflo(unsigned u) { return __uint_as_float(u << 16); }
DI float bfhi(unsigned u) { return __uint_as_float(u & 0xffff0000u); }
DI float sigmoidf_(float x) { return __builtin_amdgcn_rcpf(1.f + __expf(-x)); }

template <int CTRL>
DI float dpp_add(float x) {
  int v = __builtin_amdgcn_update_dpp(0, __float_as_int(x), CTRL, 0xF, 0xF, true);
  return x + __int_as_float(v);
}
DI float reduce16(float x) {
  x = dpp_add<0xB1>(x);
  x = dpp_add<0x4E>(x);
  x = dpp_add<0x141>(x);
  x = dpp_add<0x140>(x);
  return x;
}
using u32x4 = __attribute__((ext_vector_type(4))) unsigned;
DI u32x4 gload16(const void* p) { return *(const u32x4*)p; }
typedef __amdgpu_buffer_rsrc_t brsrc_t;
DI brsrc_t make_rsrc(const void* p) { return __builtin_amdgcn_make_buffer_rsrc((void*)p, 0, 0x7fffffff, 0x00020000); }
DI u32x4 bload16(brsrc_t r, unsigned voff, unsigned soff) { return __builtin_amdgcn_raw_buffer_load_b128(r, (int)voff, (int)soff, 0); }
DI void cfence() { asm volatile("" ::: "memory"); }
DI void vm_wait8(u32x4& a, u32x4& b, u32x4& c, u32x4& d, u32x4& e, u32x4& f, u32x4& g, u32x4& h) { cfence(); }
using u32x2 = __attribute__((ext_vector_type(2))) unsigned;
DI u32x2 gload8(const void* p) { return *(const u32x2*)p; }
DI void vm_wait5x2(u32x2& a, u32x2& b, u32x2& c, u32x2& d, u32x2& e) { cfence(); }
DI void vm_wait1(u32x4& a) {}
DI float fma_(float a, float b, float c) { float d; asm("v_fma_f32 %0, %1, %2, %3" : "=v"(d) : "v"(a), "v"(b), "v"(c)); return d; }
DI float mul_(float a, float b) { float d; asm("v_mul_f32 %0, %1, %2" : "=v"(d) : "v"(a), "v"(b)); return d; }
DI float add_(float a, float b) { float d; asm("v_add_f32 %0, %1, %2" : "=v"(d) : "v"(a), "v"(b)); return d; }
DI float sel_mask_(float keep, float take, unsigned long long mask) {
  float d;
  asm("v_cndmask_b32 %0, %1, %2, %3" : "=v"(d) : "v"(keep), "v"(take), "s"(mask));
  return d;
}
DI float add_n_(float a, float b) { float d; asm("v_add_f32 %0, %1, %2\n\ts_nop 1" : "=v"(d) : "v"(a), "v"(b)); return d; }
DI float fma_n_(float a, float b, float c) { float d; asm("v_fma_f32 %0, %1, %2, %3\n\ts_nop 1" : "=v"(d) : "v"(a), "v"(b), "v"(c)); return d; }
DI float xhalf_max(float x) {
  auto r = __builtin_amdgcn_permlane32_swap(__float_as_uint(x), __float_as_uint(x), false, false);
  return fmaxf(__uint_as_float(r[0]), __uint_as_float(r[1]));
}
DI float xhalf_sum(float x) {
  auto r = __builtin_amdgcn_permlane32_swap(__float_as_uint(x), __float_as_uint(x), false, false);
  return __uint_as_float(r[0]) + __uint_as_float(r[1]);
}
DI float wave_sum(float x) {
  x = reduce16(x);
  auto r = __builtin_amdgcn_permlane16_swap(__float_as_uint(x), __float_as_uint(x), false, false);
  x = __uint_as_float(r[0]) + __uint_as_float(r[1]);
  return xhalf_sum(x);
}

DI float* xrow(const Params& P, int row) {
  int b = row / SB, s = row - b * SB;
  if (s < CTXL) return (float*)(P.ws + OFF_SMALL + S_XC) + ((size_t)(b * CTXL + s)) * D;
  return P.out + ((size_t)b * SEQ + (s - CTXL)) * D;
}
DI const float* xrow_in(const Params& P, int row) {
  int b = row / SB, s = row - b * SB;
  if (s < CTXL) return P.in[2] + ((size_t)(b * CTXL + s)) * D;
  return P.in[0] + ((size_t)b * SEQ + (s - CTXL)) * D;
}
DI const float* modvec(const Params& P, int l, int b, int s, int chunk) {
  int vec = (s < CTXL) ? 2 : b;
  return (const float*)(P.ws + OFF_SMALL + S_MOD) + ((size_t)(l * 3 + vec) * INC) + chunk * D;
}

constexpr int TS = 132;
#define MFMA16(a, b, c) __builtin_amdgcn_mfma_f32_16x16x32_bf16((a), (b), (c), 0, 0, 0)
#define MFMA32(a, b, c) __builtin_amdgcn_mfma_f32_32x32x16_bf16((a), (b), (c), 0, 0, 0)

DI void gemm_compute(f32x4 (&acc)[4][4], const char* cA, const char* cB, int fq, int sw) {
  bf16x8 af[2][4], bfr[2][4];
#pragma unroll
  for (int kk = 0; kk < 2; ++kk) {
    const int co = (((kk * 4 + fq) ^ sw) << 4);
#pragma unroll
    for (int m = 0; m < 4; ++m) af[kk][m] = *(const bf16x8*)(cA + m * 2048 + co);
#pragma unroll
    for (int n = 0; n < 4; ++n) bfr[kk][n] = *(const bf16x8*)(cB + n * 2048 + co);
  }
  __builtin_amdgcn_sched_barrier(0);
#pragma unroll
  for (int kk = 0; kk < 2; ++kk)
#pragma unroll
    for (int m = 0; m < 4; ++m)
#pragma unroll
      for (int n = 0; n < 4; ++n) acc[m][n] = MFMA16(af[kk][m], bfr[kk][n], acc[m][n]);
}

DI void gemm_kloop(f32x4 (&acc)[4][4], const bf16_t* __restrict__ A, int lda, const bf16_t* __restrict__ Bt, int ldb,
                   int K, int b, int s0, int col0, char* smem) {
  const int tid = tidx(), lane = tid & 63, wid = tid >> 6;
  const int wr = wid >> 1, wc = wid & 1, fr = lane & 15, fq = lane >> 4;
  const int lrow = tid >> 3, lkc = tid & 7;
  const bf16_t* ap[4];
#pragma unroll
  for (int j = 0; j < 4; ++j) {
    int s = s0 + lrow + 32 * j;
    s = s < 0 ? 0 : (s > SB - 1 ? SB - 1 : s);
    ap[j] = A + (size_t)(b * SB + s) * lda + lkc * 8;
  }
  const bf16_t* bp = Bt + (size_t)(col0 + lrow) * ldb + lkc * 8;
  const size_t bstep = (size_t)32 * ldb;
  const int wofs = lrow * 128 + ((lkc ^ ((lrow >> 1) & 7)) << 4);
  char* sA = smem;
  char* sB = smem + 32768;
  const int nk = K >> 6;
  u32x4 xa[4], xb[4], ya[4], yb[4];
#define GLOAD(RA, RB, KT)                                        \
  {                                                              \
    const int kn_ = ((KT) < nk) ? (KT) : nk - 1;                 \
    _Pragma("unroll") for (int j = 0; j < 4; ++j) {              \
      RA[j] = gload16(ap[j] + kn_ * 64);                         \
      RB[j] = gload16(bp + j * bstep + kn_ * 64);                \
    }                                                            \
  }
#define LSTORE(RA, RB, P)                                        \
  {                                                              \
    char* dA_ = sA + (P) * 16384 + wofs;                         \
    char* dB_ = sB + (P) * 16384 + wofs;                         \
    _Pragma("unroll") for (int j = 0; j < 4; ++j) {              \
      *(u32x4*)(dA_ + j * 4096) = RA[j];                         \
      *(u32x4*)(dB_ + j * 4096) = RB[j];                         \
    }                                                            \
  }
  GLOAD(xa, xb, 0);
  GLOAD(ya, yb, 1);
  cfence();
  LSTORE(xa, xb, 0);
  __syncthreads();
  const int aofs = (wr * 64 + fr) * 128, bofs = (wc * 64 + fr) * 128, sw = (fr >> 1) & 7;
  for (int kt = 0; kt < nk; kt += 2) {
    GLOAD(xa, xb, kt + 2);
    cfence();
    gemm_compute(acc, sA + aofs, sB + bofs, fq, sw);
    LSTORE(ya, yb, 1);
    __syncthreads();
    if (kt + 1 < nk) {
      GLOAD(ya, yb, kt + 3);
      cfence();
      gemm_compute(acc, sA + 16384 + aofs, sB + 16384 + bofs, fq, sw);
      LSTORE(xa, xb, 0);
      __syncthreads();
    }
  }
#undef GLOAD
#undef LSTORE
}

DI void gemm_kloop1(f32x4 (&acc)[4][4], const bf16_t* __restrict__ A, int lda, const bf16_t* __restrict__ Bt, int ldb,
                   int K, int b, int s0, int col0, char* smem) {
  const int tid = tidx(), lane = tid & 63, wid = tid >> 6;
  const int wr = wid >> 1, wc = wid & 1, fr = lane & 15, fq = lane >> 4;
  const int lrow = tid >> 3, lkc = tid & 7;
  const brsrc_t rA = make_rsrc(A), rB = make_rsrc(Bt);
  unsigned aoff[4];
#pragma unroll
  for (int j = 0; j < 4; ++j) {
    int s = s0 + lrow + 32 * j;
    s = s < 0 ? 0 : (s > SB - 1 ? SB - 1 : s);
    aoff[j] = ((unsigned)(b * SB + s) * (unsigned)lda + lkc * 8) * 2u;
  }
  const unsigned boff = ((unsigned)(col0 + lrow) * (unsigned)ldb + lkc * 8) * 2u;
  const unsigned bstep = 32u * (unsigned)ldb * 2u;
  const int wofs = lrow * 128 + ((lkc ^ ((lrow >> 1) & 7)) << 4);
  char* sA = smem;
  char* sB = smem + 32768;
  const int nk = K >> 6;
  u32x4 ra[4], rb[4];
#pragma unroll
  for (int j = 0; j < 4; ++j) {
    ra[j] = bload16(rA, aoff[j], 0u);
    rb[j] = bload16(rB, boff + j * bstep, 0u);
  }
  vm_wait8(ra[0], ra[1], ra[2], ra[3], rb[0], rb[1], rb[2], rb[3]);
#pragma unroll
  for (int j = 0; j < 4; ++j) {
    *(u32x4*)(sA + wofs + j * 4096) = ra[j];
    *(u32x4*)(sB + wofs + j * 4096) = rb[j];
  }
  __syncthreads();
  const int aofs = (wr * 64 + fr) * 128, bofs = (wc * 64 + fr) * 128, sw = (fr >> 1) & 7;
  for (int kt = 0; kt < nk; ++kt) {
    const int p = kt & 1;
    {
      const int kn = (kt + 1 < nk) ? kt + 1 : kt;
#pragma unroll
      for (int j = 0; j < 4; ++j) {
        ra[j] = bload16(rA, aoff[j], (unsigned)kn * 128u);
        rb[j] = bload16(rB, boff + j * bstep, (unsigned)kn * 128u);
      }
    }
    cfence();
    const char* cA = sA + p * 16384 + aofs;
    const char* cB = sB + p * 16384 + bofs;
#pragma unroll
    for (int kk = 0; kk < 2; ++kk) {
      bf16x8 af[4], bfr[4];
      const int co = (((kk * 4 + fq) ^ sw) << 4);
#pragma unroll
      for (int m = 0; m < 4; ++m) af[m] = *(const bf16x8*)(cA + m * 2048 + co);
#pragma unroll
      for (int n = 0; n < 4; ++n) bfr[n] = *(const bf16x8*)(cB + n * 2048 + co);
#pragma unroll
      for (int m = 0; m < 4; ++m)
#pragma unroll
        for (int n = 0; n < 4; ++n) acc[m][n] = MFMA16(af[m], bfr[n], acc[m][n]);
    }
    {
      char* dA = sA + (p ^ 1) * 16384 + wofs;
      char* dB = sB + (p ^ 1) * 16384 + wofs;
      vm_wait8(ra[0], ra[1], ra[2], ra[3], rb[0], rb[1], rb[2], rb[3]);
#pragma unroll
      for (int j = 0; j < 4; ++j) {
        *(u32x4*)(dA + j * 4096) = ra[j];
        *(u32x4*)(dB + j * 4096) = rb[j];
      }
    }
    __syncthreads();
  }
}

DI void zero_acc(f32x4 (&acc)[4][4]) {
#pragma unroll
  for (int m = 0; m < 4; ++m)
#pragma unroll
    for (int n = 0; n < 4; ++n) acc[m][n] = f32x4{0.f, 0.f, 0.f, 0.f};
}

DI void acc_to_tile(const f32x4 (&acc)[4][4], float* tile) {
  const int tid = tidx(), lane = tid & 63, wid = tid >> 6;
  const int wr = wid >> 1, wc = wid & 1, fr = lane & 15, fq = lane >> 4;
#pragma unroll
  for (int m = 0; m < 4; ++m)
#pragma unroll
    for (int n = 0; n < 4; ++n)
#pragma unroll
      for (int j = 0; j < 4; ++j) tile[(wr * 64 + m * 16 + fq * 4 + j) * TS + wc * 64 + n * 16 + fr] = acc[m][n][j];
}

DI int swz4(int row) { const int g = (row >> 2) & 3; return ((g << 1) ^ ((g >> 1) * 3)) & 3; }
DI void gemm256_kloop(f32x4 (&acc)[8][4], const bf16_t* __restrict__ A, int lda, const bf16_t* __restrict__ Bt, int ldb,
                      int K, int b, int s0, int col0, char* smem) {
  const int tid = tidx(), lane = tid & 63, wid = tid >> 6;
  const int wr = wid >> 1, wc = wid & 1, fr = lane & 15, fq = lane >> 4;
  const int lrow = tid >> 2, lkc = tid & 3;
  const brsrc_t rA = make_rsrc(A), rB = make_rsrc(Bt);
  unsigned aoff[4];
#pragma unroll
  for (int j = 0; j < 4; ++j) {
    int s = s0 + lrow + 64 * j;
    s = s < 0 ? 0 : (s > SB - 1 ? SB - 1 : s);
    aoff[j] = ((unsigned)(b * SB + s) * (unsigned)lda + lkc * 8) * 2u;
  }
  const unsigned boff = ((unsigned)(col0 + lrow) * (unsigned)ldb + lkc * 8) * 2u;
  const unsigned bstep = 64u * (unsigned)ldb * 2u;
  const int wofs = lrow * 64 + ((lkc ^ swz4(lrow)) << 4);
  const int nk = K >> 5;
  u32x4 xa[4], xb[2], ya[4], yb[2];
#define GLOAD2(RA, RB, KT)                                       \
  {                                                              \
    const int kn_ = ((KT) < nk) ? (KT) : nk - 1;                 \
    _Pragma("unroll") for (int j = 0; j < 4; ++j) RA[j] = bload16(rA, aoff[j], (unsigned)kn_ * 64u); \
    _Pragma("unroll") for (int j = 0; j < 2; ++j) RB[j] = bload16(rB, boff + j * bstep, (unsigned)kn_ * 64u); \
  }
#define LSTORE2(RA, RB, P)                                       \
  {                                                              \
    char* dA_ = smem + (P) * 24576 + wofs;                       \
    _Pragma("unroll") for (int j = 0; j < 4; ++j) *(u32x4*)(dA_ + j * 4096) = RA[j]; \
    _Pragma("unroll") for (int j = 0; j < 2; ++j) *(u32x4*)(dA_ + 16384 + j * 4096) = RB[j]; \
  }
#define COMPUTE2(P)                                              \
  {                                                              \
    const char* cA_ = smem + (P) * 24576 + aofs;                 \
    const char* cB_ = smem + (P) * 24576 + 16384 + bofs;         \
    bf16x8 af_[8], bf_[4];                                       \
    _Pragma("unroll") for (int m = 0; m < 8; ++m) af_[m] = *(const bf16x8*)(cA_ + m * 1024); \
    _Pragma("unroll") for (int n = 0; n < 4; ++n) bf_[n] = *(const bf16x8*)(cB_ + n * 1024); \
    __builtin_amdgcn_s_setprio(1);                               \
    _Pragma("unroll") for (int m = 0; m < 8; ++m)                \
      _Pragma("unroll") for (int n = 0; n < 4; ++n) acc[m][n] = MFMA16(af_[m], bf_[n], acc[m][n]); \
    __builtin_amdgcn_s_setprio(0);                               \
  }
  GLOAD2(xa, xb, 0);
  GLOAD2(ya, yb, 1);
  cfence();
  LSTORE2(xa, xb, 0);
  __syncthreads();
  const int co = ((fq ^ swz4(fr)) << 4);
  const int aofs = (wr * 128 + fr) * 64 + co, bofs = (wc * 64 + fr) * 64 + co;
  for (int kt = 0; kt < nk; kt += 2) {
    GLOAD2(xa, xb, kt + 2);
    cfence();
    COMPUTE2(0);
    LSTORE2(ya, yb, 1);
    __syncthreads();
    if (kt + 1 < nk) {
      GLOAD2(ya, yb, kt + 3);
      cfence();
      COMPUTE2(1);
      LSTORE2(xa, xb, 0);
      __syncthreads();
    }
  }
#undef GLOAD2
#undef LSTORE2
#undef COMPUTE2
}

DI void acc256_to_tile(const f32x4 (&acc)[8][4], float* tile, int rowoff) {
  const int tid = tidx(), lane = tid & 63, wid = tid >> 6;
  const int wr = wid >> 1, wc = wid & 1, fr = lane & 15, fq = lane >> 4;
#pragma unroll
  for (int m = 0; m < 8; ++m) {
    const int i0 = wr * 128 + m * 16 + fq * 4 - rowoff;
#pragma unroll
    for (int j = 0; j < 4; ++j) {
      const int i = i0 + j;
      if (i >= 0 && i < 128) {
#pragma unroll
        for (int n = 0; n < 4; ++n) tile[i * TS + wc * 64 + n * 16 + fr] = acc[m][n][j];
      }
    }
  }
}

template <class Epi>
DI void gemm256_tile(const bf16_t* A, int lda, const bf16_t* Bt, int ldb, int K, int b, int s0, int col0, char* smem,
                     const Epi& epi, int rstep) {
  f32x4 acc[8][4];
#pragma unroll
  for (int m = 0; m < 8; ++m)
#pragma unroll
    for (int n = 0; n < 4; ++n) acc[m][n] = f32x4{0.f, 0.f, 0.f, 0.f};
  gemm256_kloop(acc, A, lda, Bt, ldb, K, b, s0, col0, smem);
  float* tile = (float*)smem;
#pragma unroll 1
  for (int pass = 0; pass < 2; ++pass) {
    acc256_to_tile(acc, tile, pass * rstep);
    __syncthreads();
    epi(tile, b, s0 + pass * rstep, col0);
    __syncthreads();
  }
}
template <class Epi>
DI void gemm256_item_plain(const bf16_t* A, int lda, const bf16_t* Bt, int ldb, int K, int ntn, char* smem, const Epi& epi, int it) {
  int mt = it / ntn, nt = it - mt * ntn;
  int b = mt / 65, s0 = (mt - b * 65) * 256;
  gemm256_tile(A, lda, Bt, ldb, K, b, s0, nt * 128, smem, epi, 128);
}
template <class Epi>
DI void gemm256_phase_plain(const bf16_t* A, int lda, const bf16_t* Bt, int ldb, int K, int ntn, char* smem, const Epi& epi,
                            bool skip_ctx = false) {
  if (!skip_ctx) {
    const int total = 130 * ntn;
    for (int it = bidx(); it < total; it += gdim()) gemm256_item_plain(A, lda, Bt, ldb, K, ntn, smem, epi, it);
  } else {
    const int total = 128 * ntn;
    for (int it = bidx(); it < total; it += gdim()) {
      const int mt = it / ntn, nt = it - mt * ntn;
      const int mt2 = mt + 1 + (mt >= 64 ? 1 : 0);
      gemm256_item_plain(A, lda, Bt, ldb, K, ntn, smem, epi, mt2 * ntn + nt);
    }
  }
}
template <class Epi>
DI void gemm256_phase_overlap(const bf16_t* A, int lda, const bf16_t* Bt, int ldb, int K, int ntn, char* smem, const Epi& epi) {
  const int total = 134 * ntn;
  for (int it = bidx(); it < total; it += gdim()) {
    int mt = it / ntn, nt = it - mt * ntn;
    int b = mt / 67, s0 = (mt - b * 67) * 252 - 1;
    gemm256_tile(A, lda, Bt, ldb, K, b, s0, nt * 128, smem, epi, 126);
  }
}

template <class Epi>
DI void gemm_tile(const bf16_t* A, int lda, const bf16_t* Bt, int ldb, int K, int b, int s0, int col0, char* smem,
                  const Epi& epi) {
  f32x4 acc[4][4];
  zero_acc(acc);
  gemm_kloop(acc, A, lda, Bt, ldb, K, b, s0, col0, smem);
  float* tile = (float*)smem;
  acc_to_tile(acc, tile);
  __syncthreads();
  epi(tile, b, s0, col0);
  __syncthreads();
}

DI bool same_dom(int s1, int s2) { return (s1 >= 0) && (s1 < SB) && (s2 >= 0) && (s2 < SB) && ((s1 < CTXL) == (s2 < CTXL)); }

struct EpiStore {
  bf16_t* dst; int ldd; int ncols;
  DI void operator()(const float* tile, int b, int s0, int col0) const {
    const int t = tidx(), c8 = (t & 15) * 8;
    const int n = col0 + c8;
    if (n >= ncols) return;
    for (int i = t >> 4; i < 128; i += 16) {
      size_t row = (size_t)b * SB + s0 + i;
      const float4 a = *(const float4*)(tile + i * TS + c8), c = *(const float4*)(tile + i * TS + c8 + 4);
      *(uint4*)(dst + row * ldd + n) = uint4{pack2(a.x, a.y), pack2(a.z, a.w), pack2(c.x, c.y), pack2(c.z, c.w)};
    }
  }
};

struct EpiRW {
  const float* mu; bf16_t* zrkv; bf16_t* lora; bf16_t* vf;
  DI void operator()(const float* tile, int b, int s0, int col0) const {
    if (col0 < 3072) {
      const int t = tidx(), c8 = (t & 15) * 8, n = col0 + c8;
      float m8[8];
      *(float4*)(m8) = *(const float4*)(mu + n); *(float4*)(m8 + 4) = *(const float4*)(mu + n + 4);
      for (int i = 1 + (t >> 4); i <= 126; i += 16) {
        const int s = s0 + i;
        if (s >= SB) break;
        const float* tr = tile + i * TS + c8;
        const bool hm = same_dom(s - 1, s), hp = same_dom(s + 1, s);
        float z[8], zm[8], zp[8];
        *(float4*)(z) = *(const float4*)(tr); *(float4*)(z + 4) = *(const float4*)(tr + 4);
        *(float4*)(zm) = *(const float4*)(tr - TS); *(float4*)(zm + 4) = *(const float4*)(tr - TS + 4);
        *(float4*)(zp) = *(const float4*)(tr + TS); *(float4*)(zp + 4) = *(const float4*)(tr + TS + 4);
        float o[8];
#pragma unroll
        for (int e = 0; e < 8; ++e) {
          const float nb = (hm ? zm[e] : 0.f) + (hp ? zp[e] : 0.f);
          o[e] = z[e] + m8[e] * (0.5f * nb - z[e]);
        }
        const size_t row = (size_t)b * SB + s;
        const uint4 pk = uint4{pack2(o[0], o[1]), pack2(o[2], o[3]), pack2(o[4], o[5]), pack2(o[6], o[7])};
        *(uint4*)(zrkv + row * 3072 + n) = pk;
        if (vf != nullptr && n >= 2048) *(uint4*)(vf + row * 1024 + (n - 2048)) = pk;
      }
      return;
    }
    const int t = tidx(), c2 = (t & 63) * 2;
    const int n = col0 + c2;
    if (n >= 3520) return;
    const float mu0 = mu[n], mu1 = mu[n + 1];
    for (int i = 1 + (t >> 6); i <= 126; i += 4) {
      const int s = s0 + i;
      if (s >= SB) break;
      const float* tr = tile + i * TS + c2;
      float z0 = tr[0], z1 = tr[1];
      float m0 = 0.f, m1 = 0.f, p0 = 0.f, p1 = 0.f;
      if (same_dom(s - 1, s)) { m0 = tr[-TS]; m1 = tr[-TS + 1]; }
      if (same_dom(s + 1, s)) { p0 = tr[TS]; p1 = tr[TS + 1]; }
      z0 = z0 + mu0 * (0.5f * (m0 + p0) - z0);
      z1 = z1 + mu1 * (0.5f * (m1 + p1) - z1);
      const size_t row = (size_t)b * SB + s;
      if (n < 3072) {
        unsigned pk = pack2(z0, z1);
        *(unsigned*)(zrkv + row * 3072 + n) = pk;
        if (vf != nullptr && n >= 2048) *(unsigned*)(vf + row * 1024 + (n - 2048)) = pk;
      } else if (n < 3456) {
        const int j = (n - 3072) / 96, kk = (n - 3072) - j * 96;
        if (j < 2) { z0 = 2.f * sigmoidf_(2.f * z0) - 1.f; z1 = 2.f * sigmoidf_(2.f * z1) - 1.f; }
        *(unsigned*)(lora + row * 576 + j * 128 + kk) = pack2(z0, z1);
        if (kk < 32) *(unsigned*)(lora + row * 576 + j * 128 + 96 + kk) = 0u;
      } else {
        *(unsigned*)(lora + row * 576 + 512 + (n - 3456)) = pack2(sigmoidf_(z0), sigmoidf_(z1));
      }
    }
  }
};

struct EpiDecay {
  const float* w0; bf16_t* dst;
  DI void operator()(const float* tile, int b, int s0, int col0) const {
    const int t = tidx(), c8 = (t & 15) * 8, n = col0 + c8;
    const float4 ba = *(const float4*)(w0 + n), bc = *(const float4*)(w0 + n + 4);
    const float k = 0.6065306597126334f;
    for (int i = t >> 4; i < 128; i += 16) {
      size_t row = (size_t)b * SB + s0 + i;
      const float4 a = *(const float4*)(tile + i * TS + c8), c = *(const float4*)(tile + i * TS + c8 + 4);
      *(uint4*)(dst + row * 1024 + n) =
          uint4{pack2(k * sigmoidf_(ba.x + a.x), k * sigmoidf_(ba.y + a.y)), pack2(k * sigmoidf_(ba.z + a.z), k * sigmoidf_(ba.w + a.w)),
                pack2(k * sigmoidf_(bc.x + c.x), k * sigmoidf_(bc.y + c.y)), pack2(k * sigmoidf_(bc.z + c.z), k * sigmoidf_(bc.w + c.w))};
    }
  }
};
struct EpiSigBias {
  const float* bias; bf16_t* dst; int ldd;
  DI void operator()(const float* tile, int b, int s0, int col0) const {
    const int t = tidx(), c8 = (t & 15) * 8, n = col0 + c8;
    float4 ba = {0.f, 0.f, 0.f, 0.f}, bc = {0.f, 0.f, 0.f, 0.f};
    if (bias) { ba = *(const float4*)(bias + n); bc = *(const float4*)(bias + n + 4); }
    for (int i = t >> 4; i < 128; i += 16) {
      size_t row = (size_t)b * SB + s0 + i;
      const float4 a = *(const float4*)(tile + i * TS + c8), c = *(const float4*)(tile + i * TS + c8 + 4);
      *(uint4*)(dst + row * ldd + n) =
          uint4{pack2(sigmoidf_(ba.x + a.x), sigmoidf_(ba.y + a.y)), pack2(sigmoidf_(ba.z + a.z), sigmoidf_(ba.w + a.w)),
                pack2(sigmoidf_(bc.x + c.x), sigmoidf_(bc.y + c.y)), pack2(sigmoidf_(bc.z + c.z), sigmoidf_(bc.w + c.w))};
    }
  }
};
struct EpiVres {
  const float* v0; bf16_t* zrkv; const bf16_t* vf;
  DI void operator()(const float* tile, int b, int s0, int col0) const {
    const int t = tidx(), c2 = (t & 63) * 2, n = col0 + c2;
    const float b0 = v0[n], b1 = v0[n + 1];
    for (int i = t >> 6; i < 128; i += 4) {
      size_t row = (size_t)b * SB + s0 + i;
      unsigned* pv = (unsigned*)(zrkv + row * 3072 + 2048 + n);
      unsigned uv = *pv, uf = *(const unsigned*)(vf + row * 1024 + n);
      float va = bflo(uv), vb = bfhi(uv), fa = bflo(uf), fb = bfhi(uf);
      va = va + (fa - va) * sigmoidf_(b0 + tile[i * TS + c2]);
      vb = vb + (fb - vb) * sigmoidf_(b1 + tile[i * TS + c2 + 1]);
      *pv = pack2(va, vb);
    }
  }
};

DI void rope_pair(float& a, float& bb, const float* cs, const float* sn, int t, int d) {
  float c = cs[t * 32 + d], s = sn[t * 32 + d];
  float x = a * c - bb * s, y = a * s + bb * c;
  a = x; bb = y;
}

struct EpiWA {
  bf16_t* q; bf16_t* k; bf16_t* vt; const float* cs; const float* sn;
  DI void operator()(const float* tile, int b, int s0, int col0) const {
    const int t = tidx();
    if (col0 < 1280) {
      const int g = t & 7, hb = g >> 2, d0 = (g & 3) * 8;
      const float scl = (col0 < 1024) ? 0.125f * LOG2E : 1.f;
      for (int i = t >> 3; i < 128; i += 32) {
        const int s = s0 + i;
        float a[8], bb[8];
        const float* tr = tile + i * TS + hb * 64 + d0;
        *(float4*)(a) = *(const float4*)(tr); *(float4*)(a + 4) = *(const float4*)(tr + 4);
        *(float4*)(bb) = *(const float4*)(tr + 32); *(float4*)(bb + 4) = *(const float4*)(tr + 36);
        if (s >= CTXL) {
          float c8[8], s8[8];
          const float* cp = cs + (s - CTXL) * 32 + d0; const float* sp = sn + (s - CTXL) * 32 + d0;
          *(float4*)(c8) = *(const float4*)(cp); *(float4*)(c8 + 4) = *(const float4*)(cp + 4);
          *(float4*)(s8) = *(const float4*)(sp); *(float4*)(s8 + 4) = *(const float4*)(sp + 4);
#pragma unroll
          for (int e = 0; e < 8; ++e) { const float x = a[e] * c8[e] - bb[e] * s8[e], y = a[e] * s8[e] + bb[e] * c8[e]; a[e] = x; bb[e] = y; }
        }
        size_t row = (size_t)b * SB + s;
        bf16_t* dst = (col0 < 1024) ? (q + row * 1024 + col0 + hb * 64) : (k + row * 256 + (col0 - 1024) + hb * 64);
        *(uint4*)(dst + d0) = uint4{pack2(a[0] * scl, a[1] * scl), pack2(a[2] * scl, a[3] * scl), pack2(a[4] * scl, a[5] * scl), pack2(a[6] * scl, a[7] * scl)};
        *(uint4*)(dst + d0 + 32) = uint4{pack2(bb[0] * scl, bb[1] * scl), pack2(bb[2] * scl, bb[3] * scl), pack2(bb[4] * scl, bb[5] * scl), pack2(bb[6] * scl, bb[7] * scl)};
      }
    } else {
      const int c = t >> 1, half = t & 1;
      bf16_t* dst = vt + ((size_t)b * 256 + (col0 - 1280) + c) * SB + s0 + half * 64;
      for (int g = 0; g < 8; ++g) {
        unsigned w[4];
#pragma unroll
        for (int e = 0; e < 4; ++e) {
          int i = half * 64 + g * 8 + e * 2;
          w[e] = pack2(tile[i * TS + c], tile[(i + 1) * TS + c]);
        }
        *(uint4*)(dst + g * 8) = uint4{w[0], w[1], w[2], w[3]};
      }
    }
  }
};

struct EpiMLAin {
  bf16_t* z; float* ssq;
  DI void operator()(const float* tile, int b, int s0, int col0) const {
    const int t = tidx(), c2 = (t & 63) * 2;
    const int n = col0 + c2;
    const int seg = col0 >> 9;
    for (int i = t >> 6; i < 128; i += 4) {
      size_t row = (size_t)b * SB + s0 + i;
      float v0 = tile[i * TS + c2], v1 = tile[i * TS + c2 + 1];
      if (n < 1088) *(unsigned*)(z + row * 1088 + n) = pack2(v0, v1);
      if (seg < 2) {
        float ss = wave_sum(v0 * v0 + v1 * v1);
        if ((t & 63) == 0) atomicAdd(ssq + row * 2 + seg, ss);
      }
    }
  }
};

struct EpiUQ {
  bf16_t* q; const float* ssq; const float* cs; const float* sn;
  DI void operator()(const float* tile, int b, int s0, int col0) const {
    const int t = tidx(), g = t & 7, hb = g >> 2, d0 = (g & 3) * 8;
    const int blk64 = (col0 >> 6) + hb;
    const bool roped = (blk64 % 3) == 2;
    const float scl = 0.07216878364870322f * LOG2E;
    for (int i = t >> 3; i < 128; i += 32) {
      const int s = s0 + i;
      size_t row = (size_t)b * SB + s;
      const float rs = rsqrtf(ssq[row * 2] * (1.f / 512.f) + 1e-6f) * scl;
      float a[8], bb[8];
      const float* tr = tile + i * TS + hb * 64 + d0;
      *(float4*)(a) = *(const float4*)(tr); *(float4*)(a + 4) = *(const float4*)(tr + 4);
      *(float4*)(bb) = *(const float4*)(tr + 32); *(float4*)(bb + 4) = *(const float4*)(tr + 36);
      if (roped && s >= CTXL) {
        float c8[8], s8[8];
        const float* cp = cs + (s - CTXL) * 32 + d0; const float* sp = sn + (s - CTXL) * 32 + d0;
        *(float4*)(c8) = *(const float4*)(cp); *(float4*)(c8 + 4) = *(const float4*)(cp + 4);
        *(float4*)(s8) = *(const float4*)(sp); *(float4*)(s8 + 4) = *(const float4*)(sp + 4);
#pragma unroll
        for (int e = 0; e < 8; ++e) { const float x = a[e] * c8[e] - bb[e] * s8[e], y = a[e] * s8[e] + bb[e] * c8[e]; a[e] = x; bb[e] = y; }
      }
      bf16_t* dst = q + row * LDKQ + col0 + hb * 64;
      *(uint4*)(dst + d0) = uint4{pack2(a[0] * rs, a[1] * rs), pack2(a[2] * rs, a[3] * rs), pack2(a[4] * rs, a[5] * rs), pack2(a[6] * rs, a[7] * rs)};
      *(uint4*)(dst + d0 + 32) = uint4{pack2(bb[0] * rs, bb[1] * rs), pack2(bb[2] * rs, bb[3] * rs), pack2(bb[4] * rs, bb[5] * rs), pack2(bb[6] * rs, bb[7] * rs)};
    }
  }
};

struct EpiUKV {
  bf16_t* k; bf16_t* vt; const float* ssq;
  DI void operator()(const float* tile, int b, int s0, int col0) const {
    const int t = tidx();
    const int h = col0 >> 8;
    if (((col0 >> 7) & 1) == 0) {
      const int c8 = (t & 15) * 8;
      for (int i = t >> 4; i < 128; i += 16) {
        size_t row = (size_t)b * SB + s0 + i;
        float rs = rsqrtf(ssq[row * 2 + 1] * (1.f / 512.f) + 1e-6f);
        const float4 a = *(const float4*)(tile + i * TS + c8), c = *(const float4*)(tile + i * TS + c8 + 4);
        *(uint4*)(k + row * LDKQ + h * 192 + c8) =
            uint4{pack2(a.x * rs, a.y * rs), pack2(a.z * rs, a.w * rs), pack2(c.x * rs, c.y * rs), pack2(c.z * rs, c.w * rs)};
      }
    } else {
      const int c = t >> 1, half = t & 1;
      bf16_t* dst = vt + ((size_t)b * 1024 + h * 128 + c) * SB + s0 + half * 64;
      for (int g = 0; g < 8; ++g) {
        unsigned w[4];
#pragma unroll
        for (int e = 0; e < 4; ++e) {
          int i = half * 64 + g * 8 + e * 2;
          size_t row = (size_t)b * SB + s0 + i;
          float rs0 = rsqrtf(ssq[row * 2 + 1] * (1.f / 512.f) + 1e-6f);
          float rs1 = rsqrtf(ssq[(row + 1) * 2 + 1] * (1.f / 512.f) + 1e-6f);
          w[e] = pack2(tile[i * TS + c] * rs0, tile[(i + 1) * TS + c] * rs1);
        }
        *(uint4*)(dst + g * 8) = uint4{w[0], w[1], w[2], w[3]};
      }
    }
  }
};

struct EpiResid {
  const Params* P; int l; int chunk; bool from_input;
  DI void operator()(const float* tile, int b, int s0, int col0) const {
    const int t = tidx(), c4 = (t & 31) * 4, n = col0 + c4;
    for (int i = t >> 5; i < 128; i += 8) {
      const int s = s0 + i;
      const int row = b * SB + s;
      const float* mv = modvec(*P, l, b, s, chunk);
      const float* src = from_input ? xrow_in(*P, row) : xrow(*P, row);
      float* dst = xrow(*P, row);
      const float4 xs = *(const float4*)(src + n), m4 = *(const float4*)(mv + n), a = *(const float4*)(tile + i * TS + c4);
      *(float4*)(dst + n) = float4{xs.x + m4.x * a.x, xs.y + m4.y * a.y, xs.z + m4.z * a.z, xs.w + m4.w * a.w};
    }
  }
};

struct EpiFFNin {
  const float* cw; const float* cb; bf16_t* a2;
  DI void operator()(const float* tile, int b, int s0, int col0) const {
    const int t = tidx(), c8 = (t & 7) * 8;
    const int ch = (col0 >> 7) * 64 + c8;
    float w0[8], w1[8], w2[8], bs[8];
#pragma unroll
    for (int e = 0; e < 8; ++e) { w0[e] = cw[ch + e]; w1[e] = cw[5632 + ch + e]; w2[e] = cw[2 * 5632 + ch + e]; bs[e] = cb[ch + e]; }
    for (int i = 1 + (t >> 3); i <= 126; i += 32) {
      const int s = s0 + i;
      if (s >= SB) break;
      const float* tr = tile + i * TS + c8;
      const bool hm = same_dom(s - 1, s), hp = same_dom(s + 1, s);
      float gm[8], g0[8], gp[8], u[8];
      *(float4*)(g0) = *(const float4*)(tr); *(float4*)(g0 + 4) = *(const float4*)(tr + 4);
      *(float4*)(u) = *(const float4*)(tr + 64); *(float4*)(u + 4) = *(const float4*)(tr + 68);
      *(float4*)(gm) = *(const float4*)(tr - TS); *(float4*)(gm + 4) = *(const float4*)(tr - TS + 4);
      *(float4*)(gp) = *(const float4*)(tr + TS); *(float4*)(gp + 4) = *(const float4*)(tr + TS + 4);
      float o[8];
#pragma unroll
      for (int e = 0; e < 8; ++e) {
        float a = bs[e] + w1[e] * g0[e];
        if (hm) a += w0[e] * gm[e];
        if (hp) a += w2[e] * gp[e];
        float inner = 0.7978845608028654f * (a + 0.044715f * a * a * a);
        o[e] = a * sigmoidf_(2.f * inner) * u[e];
      }
      *(uint4*)(a2 + ((size_t)b * SB + s) * LDA2 + ch) = uint4{pack2(o[0], o[1]), pack2(o[2], o[3]), pack2(o[4], o[5]), pack2(o[6], o[7])};
    }
  }
};

DI void conv_tile(const float* __restrict__ src, int Ksrc, int N, bf16_t* __restrict__ dst, int ldd, int kt, int nt, int perm,
                  const float* kscale, float* sm) {
  const int tid = tidx();
  const int k0 = kt * 64, n0 = nt * 64;
  {
    const int j = tid & 63;
    for (int i = tid >> 6; i < 64; i += 4) {
      float v = 0.f;
      if (k0 + i < Ksrc) {
        v = src[(size_t)(k0 + i) * N + n0 + j];
        if (kscale) v *= kscale[k0 + i];
      }
      sm[i * 65 + j] = v;
    }
  }
  __syncthreads();
  int r0 = n0;
  if (perm) r0 = (n0 < 5632) ? ((n0 >> 6) * 128) : ((((n0 - 5632) >> 6) * 128) + 64);
  {
    const int i2 = (tid & 31) * 2;
    for (int j = tid >> 5; j < 64; j += 8)
      *(unsigned*)(dst + (size_t)(r0 + j) * ldd + k0 + i2) = pack2(sm[i2 * 65 + j], sm[(i2 + 1) * 65 + j]);
  }
  __syncthreads();
}

DI void conv_tile_w(const float* __restrict__ src, int Ksrc, int N, bf16_t* __restrict__ dst, int ldd, int kt, int nt, int perm,
                    const float* kscale, float* sm) {
  const int tid = tidx();
  const int k0 = kt * 64, n0 = nt * 128;
  {
    const int j2 = (tid & 63) * 2;
    for (int i = tid >> 6; i < 64; i += 4) {
      float2 v = {0.f, 0.f};
      if (k0 + i < Ksrc) {
        v = *(const float2*)(src + (size_t)(k0 + i) * N + n0 + j2);
        if (kscale) { const float ks = kscale[k0 + i]; v.x *= ks; v.y *= ks; }
      }
      sm[i * 129 + j2] = v.x;
      sm[i * 129 + j2 + 1] = v.y;
    }
  }
  __syncthreads();
  {
    const int i2 = (tid & 31) * 2;
    for (int j = tid >> 5; j < 128; j += 8) {
      const int n = n0 + j;
      int r = n;
      if (perm) r = (n < 5632) ? ((n >> 6) * 128 + (n & 63)) : ((((n - 5632) >> 6) * 128) + 64 + ((n - 5632) & 63));
      *(unsigned*)(dst + (size_t)r * ldd + k0 + i2) = pack2(sm[i2 * 129 + j], sm[(i2 + 1) * 129 + j]);
    }
  }
  __syncthreads();
}

struct ConvJob { const float* src; bf16_t* dst; int K, N, ldd, perm; const float* ks; };
DI int job_tiles(const ConvJob& j) { return ((j.K + 63) >> 6) * ((j.N & 127) ? (j.N >> 6) : (j.N >> 7)); }
DI void run_job_tile(const ConvJob& j, int t, float* sm) {
  if (j.N & 127) {
    const int ntn = j.N >> 6;
    conv_tile(j.src, j.K, j.N, j.dst, j.ldd, t / ntn, t % ntn, j.perm, j.ks, sm);
  } else {
    const int ntn = j.N >> 7;
    conv_tile_w(j.src, j.K, j.N, j.dst, j.ldd, t / ntn, t % ntn, j.perm, j.ks, sm);
  }
}
DI bool get_wjob(const Params& P, int l, int j, ConvJob& o) {
  char* W = P.ws + OFF_W;
  switch (j) {
    case 0: o = ConvJob{P.in[7] + (size_t)l * D * INC, (bf16_t*)(W + W_IN), D, INC, LDW, 0, nullptr}; return true;
    case 1: case 2: case 3:
      o = ConvJob{P.in[27] + ((size_t)l * 3 + (j - 1)) * 1024 * D, (bf16_t*)(W + W_BR) + (size_t)(j - 1) * D * LDWB, 1024, D, LDWB, 0, nullptr}; return true;
    case 4: o = ConvJob{P.in[28] + (size_t)l * D * D, (bf16_t*)(W + W_OUT), D, D, LDW, 0, nullptr}; return true;
    case 5: o = ConvJob{P.in[25] + (size_t)l * 512 * 1536, (bf16_t*)(W + W_UQ), 512, 1536, LDUQ, 0, P.in[23] + l * 512}; return true;
    case 6: o = ConvJob{P.in[26] + (size_t)l * 512 * 2048, (bf16_t*)(W + W_UKV), 512, 2048, LDUQ, 0, P.in[24] + l * 512}; return true;
    case 7: case 8:
      o = ConvJob{P.in[10] + ((size_t)l * 2 + (j - 7)) * 96 * 1024, (bf16_t*)(W + W_W2) + (size_t)(j - 7) * 1024 * 128, 96, 1024, 128, 0, nullptr}; return true;
    case 9: case 10:
      o = ConvJob{P.in[12] + ((size_t)l * 2 + (j - 9)) * 96 * 1024, (bf16_t*)(W + W_A2) + (size_t)(j - 9) * 1024 * 128, 96, 1024, 128, 0, nullptr}; return true;
    case 11: o = ConvJob{P.in[13] + (size_t)l * 64 * 1024, (bf16_t*)(W + W_G2), 64, 1024, 64, 0, nullptr}; return true;
    case 12: if (l < 1) return false;
      o = ConvJob{P.in[20] + (size_t)(l - 1) * 1024 * 64, (bf16_t*)(W + W_V1), 1024, 64, 1024, 0, nullptr}; return true;
    case 13: if (l < 1) return false;
      o = ConvJob{P.in[21] + (size_t)(l - 1) * 64 * 1024, (bf16_t*)(W + W_V2), 64, 1024, 64, 0, nullptr}; return true;
  }
  return false;
}
DI void get_fjob(const Params& P, int l, int j, ConvJob& o) {
  char* Bg = P.ws + OFF_BIG;
  if (j == 0) o = ConvJob{P.in[30] + (size_t)l * D * 11264, (bf16_t*)(Bg + B_WFIN), D, 11264, LDW, 1, nullptr};
  else o = ConvJob{P.in[33] + (size_t)l * 5632 * D, (bf16_t*)(Bg + B_WFOUT), 5632, D, LDA2, 0, nullptr};
}
DI void run_conv_item(const Params& P, int lw, int lf, int it, float* sm) {
  ConvJob jb;
  if (lw >= 0) {
    for (int j = 0; j < 14; ++j) {
      if (!get_wjob(P, lw, j, jb)) continue;
      int nt = job_tiles(jb);
      if (it < nt) { run_job_tile(jb, it, sm); return; }
      it -= nt;
    }
  }
  if (lf >= 0) {
    for (int j = 0; j < 2; ++j) {
      get_fjob(P, lf, j, jb);
      int nt = job_tiles(jb);
      if (it < nt) { run_job_tile(jb, it, sm); return; }
      it -= nt;
    }
  }
}
DI int conv_total(int lw, int lf) {
  int n = 0;
  if (lw >= 0) n += 3072 + 3 * 256 + 512 + 96 + 128 + 4 * 16 + 8 + (lw >= 1 ? 16 + 8 : 0);
  if (lf >= 0) n += 32 * 88 + 88 * 16;
  return n;
}

DI void phase_init(const Params& P, char* smem) {
  float* cs = (float*)(P.ws + OFF_SMALL + S_COS);
  float* sn = (float*)(P.ws + OFF_SMALL + S_SIN);
  for (int idx = bidx() * 256 + tidx(); idx < SEQ * 32; idx += gdim() * 256) {
    int t = idx >> 5, d = idx & 31, f = d & 15;
    float inv = powf(10000.f, -(float)f / 16.f);
    float pos = (d < 16) ? (float)(t >> 6) : (float)(t & 63);
    float ang = pos * inv;
    cs[idx] = cosf(ang);
    sn[idx] = sinf(ang);
  }
  float* part = (float*)(P.ws + OFF_OA);
  const int nmod = 2 * 16 * 12;
  const int ntot = nmod + conv_total(0, -1);
  for (int it = bidx(); it < ntot; it += gdim()) {
    if (it < nmod) {
      int l = it / 192, r = it % 192, kc = r / 12, nc = r % 12;
      int n = nc * 1024 + tidx() * 4;
      float4 a0 = {0, 0, 0, 0}, a1 = {0, 0, 0, 0}, a2 = {0, 0, 0, 0};
      const float* w = P.in[4] + (size_t)l * D * INC + n;
      for (int k = kc * 128; k < kc * 128 + 128; ++k) {
        float c0 = P.in[1][k], c1 = P.in[1][D + k], c2 = P.in[3][k];
        c0 = c0 * sigmoidf_(c0); c1 = c1 * sigmoidf_(c1); c2 = c2 * sigmoidf_(c2);
        float4 wv = *(const float4*)(w + (size_t)k * INC);
        a0.x += c0 * wv.x; a0.y += c0 * wv.y; a0.z += c0 * wv.z; a0.w += c0 * wv.w;
        a1.x += c1 * wv.x; a1.y += c1 * wv.y; a1.z += c1 * wv.z; a1.w += c1 * wv.w;
        a2.x += c2 * wv.x; a2.y += c2 * wv.y; a2.z += c2 * wv.z; a2.w += c2 * wv.w;
      }
      float* pp = part + ((size_t)(l * 16 + kc) * 3) * INC + n;
      *(float4*)(pp) = a0;
      *(float4*)(pp + INC) = a1;
      *(float4*)(pp + 2 * INC) = a2;
    } else {
      run_conv_item(P, 0, -1, it - nmod, (float*)smem);
    }
  }
}

DI void phase_modred(const Params& P) {
  const float* part = (const float*)(P.ws + OFF_OA);
  float* mod = (float*)(P.ws + OFF_SMALL + S_MOD);
  for (int idx = bidx() * 256 + tidx(); idx < 2 * 3 * INC; idx += gdim() * 256) {
    int l = idx / (3 * INC), r = idx % (3 * INC), j = r / INC, n = r % INC;
    float a = P.in[5][l * INC + n];
    for (int kc = 0; kc < 16; ++kc) a += part[((size_t)(l * 16 + kc) * 3 + j) * INC + n];
    mod[idx] = a;
  }
}

DI void phase_norm(const Params& P, int l, int which) {
  const int lane = tidx() & 63, wid = tidx() >> 6;
  bf16_t* H = (bf16_t*)(P.ws + OFF_H);
  const float* g = (which == 1 ? P.in[6] : P.in[29]) + l * D;
  if (which == 1) {
    float* ssq = (float*)(P.ws + OFF_SMALL + S_SSQ);
    for (int idx = bidx() * 256 + tidx(); idx < T * 2; idx += gdim() * 256) ssq[idx] = 0.f;
  }
  for (int row = bidx() * 4 + wid; row < T; row += gdim() * 4) {
    const int b = row / SB, s = row - b * SB;
    const float* xr = (which == 1 && l == 0) ? xrow_in(P, row) : xrow(P, row);
    const float* sh = modvec(P, l, b, s, which == 1 ? 0 : 3);
    const float* sc = modvec(P, l, b, s, which == 1 ? 1 : 4);
    float4 v[8];
    float ss = 0.f;
#pragma unroll
    for (int i = 0; i < 8; ++i) {
      v[i] = *(const float4*)(xr + lane * 4 + i * 256);
      ss += v[i].x * v[i].x + v[i].y * v[i].y + v[i].z * v[i].z + v[i].w * v[i].w;
    }
    ss = wave_sum(ss);
    const float rs = rsqrtf(ss * (1.f / 2048.f) + 1e-6f);
#pragma unroll
    for (int i = 0; i < 8; ++i) {
      const int c = lane * 4 + i * 256;
      float4 gg = *(const float4*)(g + c), s4 = *(const float4*)(sh + c), c4 = *(const float4*)(sc + c);
      float o0 = v[i].x * rs * gg.x * (1.f + c4.x) + s4.x;
      float o1 = v[i].y * rs * gg.y * (1.f + c4.y) + s4.y;
      float o2 = v[i].z * rs * gg.z * (1.f + c4.z) + s4.z;
      float o3 = v[i].w * rs * gg.w * (1.f + c4.w) + s4.w;
      *(uint2*)(H + (size_t)row * LDH + c) = uint2{pack2(o0, o1), pack2(o2, o3)};
    }
  }
}

DI void phase_final(const Params& P) {
  const int lane = tidx() & 63, wid = tidx() >> 6;
  const float* g = P.in[34];
  for (int r = bidx() * 4 + wid; r < 2 * SEQ; r += gdim() * 4) {
    float* xr = P.out + (size_t)r * D;
    float4 v[8];
    float ss = 0.f;
#pragma unroll
    for (int i = 0; i < 8; ++i) {
      v[i] = *(const float4*)(xr + lane * 4 + i * 256);
      ss += v[i].x * v[i].x + v[i].y * v[i].y + v[i].z * v[i].z + v[i].w * v[i].w;
    }
    ss = wave_sum(ss);
    const float rs = rsqrtf(ss * (1.f / 2048.f) + 1e-6f);
#pragma unroll
    for (int i = 0; i < 8; ++i) {
      const int c = lane * 4 + i * 256;
      float4 gg = *(const float4*)(g + c);
      *(float4*)(xr + c) = float4{v[i].x * rs * gg.x, v[i].y * rs * gg.y, v[i].z * rs * gg.z, v[i].w * rs * gg.w};
    }
  }
}

template <class Epi>
DI void gemm_item_plain(const bf16_t* A, int lda, const bf16_t* Bt, int ldb, int K, int ntn, char* smem, const Epi& epi, int it) {
  int mt = it / ntn, nt = it - mt * ntn;
  int b = mt / 130, s0 = (mt - b * 130) * 128;
  gemm_tile(A, lda, Bt, ldb, K, b, s0, nt * 128, smem, epi);
}
template <class Epi>
DI void gemm_phase_plain(const bf16_t* A, int lda, const bf16_t* Bt, int ldb, int K, int ntn, char* smem, const Epi& epi) {
  const int total = 260 * ntn;
  for (int it = bidx(); it < total; it += gdim()) gemm_item_plain(A, lda, Bt, ldb, K, ntn, smem, epi, it);
}
template <class Epi>
DI void gemm_phase_overlap(const bf16_t* A, int lda, const bf16_t* Bt, int ldb, int K, int ntn, char* smem, const Epi& epi) {
  const int total = 266 * ntn;
  for (int it = bidx(); it < total; it += gdim()) {
    int mt = it / ntn, nt = it - mt * ntn;
    int b = mt / 133, s0 = (mt - b * 133) * 126 - 1;
    gemm_tile(A, lda, Bt, ldb, K, b, s0, nt * 128, smem, epi);
  }
}

DI void phase_lora(const Params& P, int l, char* smem) {
  char* W = P.ws + OFF_W; char* Bg = P.ws + OFF_BIG;
  const bf16_t* lora = (const bf16_t*)(Bg + B_LORA);
  if (bidx() == 0) {
    int* cnt = (int*)(P.ws + OFF_SMALL + S_CNT);
    for (int i = tidx(); i < 4096 + 64; i += 256) cnt[i] = 0;
  }
  const int per = 260 * 8;
  const int total = 5 * per + (l >= 1 ? 260 : 0);
  for (int it = bidx(); it < total; it += gdim()) {
    int j = it / per, r = it - j * per;
    if (j < 2) {
      EpiDecay e{P.in[9] + (size_t)(l * 2 + j) * 1024, (bf16_t*)(Bg + (j == 0 ? B_EF : B_EB))};
      gemm_item_plain(lora + j * 128, 576, (const bf16_t*)(W + W_W2) + (size_t)j * 1024 * 128, 128, 128, 8, smem, e, r);
    } else if (j < 4) {
      EpiSigBias e{P.in[11] + (size_t)(l * 2 + (j - 2)) * 1024, (bf16_t*)(Bg + (j == 2 ? B_AF : B_AB)), 1024};
      gemm_item_plain(lora + j * 128, 576, (const bf16_t*)(W + W_A2) + (size_t)(j - 2) * 1024 * 128, 128, 128, 8, smem, e, r);
    } else if (j == 4) {
      EpiStore e{(bf16_t*)(P.ws + OFF_OA), 1024, 1024};
      gemm_item_plain(lora + 512, 576, (const bf16_t*)(W + W_G2), 64, 64, 8, smem, e, r);
    } else {
      EpiStore e{(bf16_t*)(P.ws + OFF_SMALL + S_TV1), 64, 64};
      gemm_item_plain((const bf16_t*)(Bg + B_ZRKV) + 2048, 3072, (const bf16_t*)(W + W_V1), 1024, 1024, 1, smem, e, r);
    }
  }
}

DI void scan_load(u32x2 (&raw)[5], const bf16_t* R, const bf16_t* E, const bf16_t* Aa, int b, int dir, int i, int k4) {
  int s = dir == 0 ? i : (i < 256 ? 255 - i : 16895 - i);
  size_t row = (size_t)b * SB + s;
  raw[0] = gload8(R + row * 3072 + k4);
  raw[1] = gload8(R + row * 3072 + 1024 + k4);
  raw[2] = gload8(R + row * 3072 + 2048 + k4);
  raw[3] = gload8(E + row * 1024 + k4);
  raw[4] = gload8(Aa + row * 1024 + k4);
}
DI void scan_prep(u32x2 (&raw)[5], const float (&kkw)[4], const float (&kaw)[4], float* dst  ) {
  vm_wait5x2(raw[0], raw[1], raw[2], raw[3], raw[4]);
  float r[4] = {bflo(raw[0].x), bfhi(raw[0].x), bflo(raw[0].y), bfhi(raw[0].y)};
  float k[4] = {bflo(raw[1].x), bfhi(raw[1].x), bflo(raw[1].y), bfhi(raw[1].y)};
  float v[4] = {bflo(raw[2].x), bfhi(raw[2].x), bflo(raw[2].y), bfhi(raw[2].y)};
  float e[4] = {bflo(raw[3].x), bfhi(raw[3].x), bflo(raw[3].y), bfhi(raw[3].y)};
  float a[4] = {bflo(raw[4].x), bfhi(raw[4].x), bflo(raw[4].y), bfhi(raw[4].y)};
  float kr[4], ss = 0.f;
#pragma unroll
  for (int i = 0; i < 4; ++i) { kr[i] = mul_(k[i], kkw[i]); ss = (i < 3) ? fma_(kr[i], kr[i], ss) : fma_n_(kr[i], kr[i], ss); }
  ss = reduce16(ss);
  const float inv = __builtin_amdgcn_rcpf(fmaxf(__builtin_amdgcn_sqrtf(ss), 1e-12f));
  float w4[4], kd4[4], a4[4], b4[4];
#pragma unroll
  for (int i = 0; i < 4; ++i) {
    float kn = kr[i] * inv;
    w4[i] = __builtin_amdgcn_exp2f(mul_(e[i], -LOG2E));
    kd4[i] = mul_(k[i], fma_(add_(a[i], -1.f), kaw[i], 1.f));
    a4[i] = -kn;
    b4[i] = mul_(kn, a[i]);
  }
  *(float4*)(dst) = float4{r[0], r[1], r[2], r[3]};
  *(float4*)(dst + 64) = float4{w4[0], w4[1], w4[2], w4[3]};
  *(float4*)(dst + 128) = float4{kd4[0], kd4[1], kd4[2], kd4[3]};
  *(float4*)(dst + 192) = float4{a4[0], a4[1], a4[2], a4[3]};
  *(float4*)(dst + 256) = float4{b4[0], b4[1], b4[2], b4[3]};
  *(float4*)(dst + 320) = float4{v[0], v[1], v[2], v[3]};
}

DI void phase_scan(const Params& P, int l, char* smem) {
  char* Bg = P.ws + OFF_BIG;
  const int tid = tidx();
  const int st = tid >> 4, kl = tid & 15, k4 = kl * 4;
  float* buf = (float*)smem;
  for (int item = bidx(); item < 256; item += gdim()) {
    const int inst = item >> 2, vb = item & 3;
    const int b = inst >> 5, h = (inst >> 1) & 15, dir = inst & 1;
    const bf16_t* R = (const bf16_t*)(Bg + B_ZRKV) + h * 64;
    const bf16_t* E = (const bf16_t*)(Bg + (dir ? B_EB : B_EF)) + h * 64;
    const bf16_t* Aa = (const bf16_t*)(Bg + (dir ? B_AB : B_AF)) + h * 64;
    bf16_t* Y = (bf16_t*)(P.ws + (dir ? OFF_OC : OFF_OB)) + h * 64 + vb * 16;
    float kkw[4], kaw[4];
#pragma unroll
    for (int i = 0; i < 4; ++i) {
      kkw[i] = P.in[14][l * 1024 + h * 64 + k4 + i];
      kaw[i] = P.in[15][l * 1024 + h * 64 + k4 + i];
    }
    float S0 = 0.f, S1 = 0.f, S2 = 0.f, S3 = 0.f;
    u32x2 raw[5];
    scan_load(raw, R, E, Aa, b, dir, st, k4);
    scan_prep(raw, kkw, kaw, buf + st * 384 + k4);
    __syncthreads();
    const int nchunk = SB / 16;
    for (int c = 0; c < nchunk; ++c) {
      if (c + 1 < nchunk) scan_load(raw, R, E, Aa, b, dir, (c + 1) * 16 + st, k4);
      cfence();
      const float* cb = buf + (c & 1) * (16 * 384);
      float ykeep = 0.f;
#define SCAN_LOAD(SET, G)                                                          \
  _Pragma("unroll") for (int q_ = 0; q_ < 4; ++q_) {                                \
    const float* sb_ = cb + ((G) * 4 + q_) * 384;                                   \
    SET##r[q_] = *(const float4*)(sb_ + k4);                                        \
    SET##w[q_] = *(const float4*)(sb_ + 64 + k4);                                   \
    SET##k[q_] = *(const float4*)(sb_ + 128 + k4);                                  \
    SET##a[q_] = *(const float4*)(sb_ + 192 + k4);                                  \
    SET##b[q_] = *(const float4*)(sb_ + 256 + k4);                                  \
    SET##v[q_] = sb_[320 + vb * 16 + st];                                           \
  }
#define SCAN_STEPS(SET, G)                                                         \
  _Pragma("unroll") for (int q_ = 0; q_ < 4; ++q_) {                                \
    const float4 r4 = SET##r[q_], w4 = SET##w[q_], kd = SET##k[q_], a4 = SET##a[q_], b4 = SET##b[q_]; \
    const float vv = SET##v[q_];                                                    \
    float sa = fma_n_(S3, a4.w, fma_(S2, a4.z, fma_(S1, a4.y, mul_(S0, a4.x)))); \
    const float z0 = fma_(S0, w4.x, mul_(vv, kd.x)), z1 = fma_(S1, w4.y, mul_(vv, kd.y)); \
    const float z2 = fma_(S2, w4.z, mul_(vv, kd.z)), z3 = fma_(S3, w4.w, mul_(vv, kd.w)); \
    sa = reduce16(sa);                                                              \
    S0 = fma_(sa, b4.x, z0);                                                        \
    S1 = fma_(sa, b4.y, z1);                                                        \
    S2 = fma_(sa, b4.z, z2);                                                        \
    S3 = fma_(sa, b4.w, z3);                                                        \
    float y = fma_n_(S3, r4.w, fma_(S2, r4.z, fma_(S1, r4.y, mul_(S0, r4.x)))); \
    y = reduce16(y);                                                                \
    ykeep = sel_mask_(ykeep, y, 0x0001000100010001ull << ((G) * 4 + q_));            \
  }
      {
        float4 Ar[4], Aw[4], Ak[4], Aa[4], Ab[4], Br[4], Bw[4], Bk[4], Ba[4], Bb[4];
        float Av[4], Bv[4];
        SCAN_LOAD(A, 0);
        SCAN_LOAD(B, 1);
        SCAN_STEPS(A, 0);
        SCAN_LOAD(A, 2);
        SCAN_STEPS(B, 1);
        SCAN_LOAD(B, 3);
        SCAN_STEPS(A, 2);
        SCAN_STEPS(B, 3);
      }
#undef SCAN_LOAD
#undef SCAN_STEPS
      {
        int i = c * 16 + kl;
        int s = dir == 0 ? i : (i < 256 ? 255 - i : 16895 - i);
        Y[((size_t)b * SB + s) * 1024 + st] = f2bf(ykeep);
      }
      if (c + 1 < nchunk) scan_prep(raw, kkw, kaw, buf + ((c + 1) & 1) * (16 * 384) + st * 384 + k4);
      __syncthreads();
    }
  }
}

DI void phase_post(const Params& P, int l) {
  char* Bg = P.ws + OFF_BIG;
  const bf16_t* Z = (const bf16_t*)(Bg + B_ZRKV);
  const bf16_t* AF = (const bf16_t*)(Bg + B_AF);
  const bf16_t* AB = (const bf16_t*)(Bg + B_AB);
  const bf16_t* YF = (const bf16_t*)(P.ws + OFF_OB);
  const bf16_t* YB = (const bf16_t*)(P.ws + OFF_OC);
  bf16_t* OA = (bf16_t*)(P.ws + OFF_OA);
  const int kl = tidx() & 15;
  const int ngroups = T * 16;
  for (int gidx = bidx() * 16 + (tidx() >> 4); gidx < ngroups; gidx += gdim() * 16) {
    const int row = gidx >> 4, h = gidx & 15;
    const int c = h * 64 + kl * 4;
    uint2 uyf = *(const uint2*)(YF + (size_t)row * 1024 + c), uyb = *(const uint2*)(YB + (size_t)row * 1024 + c);
    float y[4] = {bflo(uyf.x) + bflo(uyb.x), bfhi(uyf.x) + bfhi(uyb.x), bflo(uyf.y) + bflo(uyb.y), bfhi(uyf.y) + bfhi(uyb.y)};
    float mean = reduce16(y[0] + y[1] + y[2] + y[3]) * (1.f / 64.f);
    float dd[4] = {y[0] - mean, y[1] - mean, y[2] - mean, y[3] - mean};
    float var = reduce16(dd[0] * dd[0] + dd[1] * dd[1] + dd[2] * dd[2] + dd[3] * dd[3]) * (1.f / 64.f);
    float rstd = rsqrtf(var + 64e-5f);
    uint2 ur = *(const uint2*)(Z + (size_t)row * 3072 + c), uk = *(const uint2*)(Z + (size_t)row * 3072 + 1024 + c),
          uv = *(const uint2*)(Z + (size_t)row * 3072 + 2048 + c);
    uint2 uaf = *(const uint2*)(AF + (size_t)row * 1024 + c), uab = *(const uint2*)(AB + (size_t)row * 1024 + c);
    uint2 ug = *(const uint2*)(OA + (size_t)row * 1024 + c);
    float r[4] = {bflo(ur.x), bfhi(ur.x), bflo(ur.y), bfhi(ur.y)};
    float k[4] = {bflo(uk.x), bfhi(uk.x), bflo(uk.y), bfhi(uk.y)};
    float v[4] = {bflo(uv.x), bfhi(uv.x), bflo(uv.y), bfhi(uv.y)};
    float af[4] = {bflo(uaf.x), bfhi(uaf.x), bflo(uaf.y), bfhi(uaf.y)};
    float ab[4] = {bflo(uab.x), bfhi(uab.x), bflo(uab.y), bfhi(uab.y)};
    float g[4] = {bflo(ug.x), bfhi(ug.x), bflo(ug.y), bfhi(ug.y)};
    float bon = 0.f;
#pragma unroll
    for (int i = 0; i < 4; ++i) {
      float ka = P.in[15][l * 1024 + c + i];
      float ksum = k[i] * (2.f + (af[i] + ab[i] - 2.f) * ka);
      bon += r[i] * ksum * P.in[16][l * 1024 + c + i];
    }
    bon = reduce16(bon);
    float o[4];
#pragma unroll
    for (int i = 0; i < 4; ++i) {
      float yn = dd[i] * rstd * P.in[17][l * 1024 + c + i] + P.in[18][l * 1024 + c + i];
      o[i] = (yn + bon * v[i]) * g[i];
    }
    *(uint2*)(OA + (size_t)row * 1024 + c) = uint2{pack2(o[0], o[1]), pack2(o[2], o[3])};
  }
}

DI int vswz(int d) { const int g = (d >> 2) & 7; return (g ^ ((g >> 2) * 3)) & 3; }
template <int DQK, int DV>
struct AttnMap {
  unsigned koff[DQK / 64], kl[DQK / 64];
  unsigned voff[DV / 64], vl0[DV / 64], vl1[DV / 64];
  DI void init(int ldk) {
    const int tid = tidx();
    constexpr int CPR = DQK / 8;
#pragma unroll
    for (int j = 0; j < DQK / 64; ++j) {
      int c = tid + 256 * j, row = c / CPR, kc = c - row * CPR;
      int pc = (kc & ~7) | ((kc & 7) ^ ((row >> 1) & 7));
      koff[j] = (unsigned)(row * ldk + kc * 8) * 2u;
      kl[j] = (unsigned)(row * (DQK * 2) + pc * 16);
    }
#pragma unroll
    for (int j = 0; j < DV / 64; ++j) {
      int c = tid + 256 * j, d = c >> 2, part = c & 3, f = vswz(d);
      voff[j] = (unsigned)(d * SB + part * 8) * 2u;
      vl0[j] = (unsigned)(d * 64 + (((2 * (part >> 1)) ^ f) << 4) + (part & 1) * 8);
      vl1[j] = (unsigned)(d * 64 + (((2 * (part >> 1) + 1) ^ f) << 4) + (part & 1) * 8);
    }
  }
};
template <int DQK, int DV>
DI void attn_load(u32x4 (&rk)[DQK / 64], u32x4 (&rv)[DV / 64], const AttnMap<DQK, DV>& mp, brsrc_t Kr, int ldk, brsrc_t Vr, int key0) {
  const unsigned ks = (unsigned)key0 * (unsigned)(ldk * 2), vs = (unsigned)key0 * 2u;
#pragma unroll
  for (int j = 0; j < DQK / 64; ++j) rk[j] = bload16(Kr, mp.koff[j], ks);
#pragma unroll
  for (int j = 0; j < DV / 64; ++j) rv[j] = bload16(Vr, mp.voff[j], vs);
}
template <int DQK, int DV>
DI void attn_store(u32x4 (&rk)[DQK / 64], u32x4 (&rv)[DV / 64], const AttnMap<DQK, DV>& mp, char* sK, char* sV) {
#pragma unroll
  for (int j = 0; j < DQK / 64; ++j) *(u32x4*)(sK + mp.kl[j]) = rk[j];
#pragma unroll
  for (int j = 0; j < DV / 64; ++j) {
    *(uint2*)(sV + mp.vl0[j]) = uint2{rv[j].x, rv[j].y};
    *(uint2*)(sV + mp.vl1[j]) = uint2{rv[j].z, rv[j].w};
  }
}

template <int DQK, int DV>
DI void attn_tile(const bf16_t* Q, int ldq, const bf16_t* Kb, int ldk, const bf16_t* Vt, bf16_t* O, int ldo, int b, int sq0,
                  int r0a, int r0b, int r1a, int r1b, float m_init, float l_init, char* smem) {
  const int tid = tidx(), lane = tid & 63, wid = tid >> 6;
  const int ql = lane & 31, hh = lane >> 5;
  constexpr int NS = DQK / 16, NB = DV / 32;
  constexpr int KB = 32 * DQK * 2, VB = DV * 64, BUF = KB + VB;
  const int qs = sq0 + wid * 32 + ql;
  bf16x8 qf[NS];
  {
    const bf16_t* qp = Q + (size_t)(b * SB + qs) * ldq + 8 * hh;
#pragma unroll
    for (int s = 0; s < NS; ++s) qf[s] = *(const bf16x8*)(qp + 16 * s);
  }
  f32x16 acc[NB];
#pragma unroll
  for (int i = 0; i < NB; ++i)
#pragma unroll
    for (int r = 0; r < 16; ++r) acc[i][r] = 0.f;
  float m = m_init, lsum = l_init;
  const int n0 = (r0b - r0a) >> 5, n1 = (r1b > r1a) ? ((r1b - r1a) >> 5) : 0;
  const int nt = n0 + n1;
  const brsrc_t Kbase = make_rsrc(Kb + (size_t)b * SB * ldk);
  const brsrc_t Vbase = make_rsrc(Vt);
  AttnMap<DQK, DV> mp;
  mp.init(ldk);
  u32x4 rk[DQK / 64], rv[DV / 64];
  attn_load<DQK, DV>(rk, rv, mp, Kbase, ldk, Vbase, r0a);
  attn_store<DQK, DV>(rk, rv, mp, smem, smem + KB);
  __syncthreads();
  for (int it = 0; it < nt; ++it) {
    const int key0 = it < n0 ? r0a + 32 * it : r1a + 32 * (it - n0);
    const bool masked = it >= n0;
    {
      const int itn = (it + 1 < nt) ? it + 1 : it;
      const int nk0 = itn < n0 ? r0a + 32 * itn : r1a + 32 * (itn - n0);
      attn_load<DQK, DV>(rk, rv, mp, Kbase, ldk, Vbase, nk0);
    }
    cfence();
    const char* sK = smem + (it & 1) * BUF;
    const char* sV = sK + KB;
    f32x16 S;
#pragma unroll
    for (int r = 0; r < 16; ++r) S[r] = 0.f;
    {
      const char* kr = sK + ql * (DQK * 2);
      const int f = (ql >> 1) & 7;
#pragma unroll
      for (int s = 0; s < NS; ++s) {
        const int c = 2 * s + hh;
        const int pc = (c & ~7) | ((c & 7) ^ f);
        bf16x8 kf = *(const bf16x8*)(kr + pc * 16);
        S = MFMA32(kf, qf[s], S);
      }
    }
    if (masked) {
#pragma unroll
      for (int r = 0; r < 16; ++r) {
        int ks = key0 + (r & 3) + 8 * (r >> 2) + 4 * hh;
        int df = ks - qs;
        if (df > 128 || df < -128) S[r] = -1e30f;
      }
    }
    float mx = S[0];
#pragma unroll
    for (int r = 1; r < 16; ++r) mx = fmaxf(mx, S[r]);
    mx = xhalf_max(mx);
    const float mn = fmaxf(m, mx);
    const float alpha = __builtin_amdgcn_exp2f(m - mn);
    m = mn;
    float p[16], rsum = 0.f;
#pragma unroll
    for (int r = 0; r < 16; ++r) { p[r] = __builtin_amdgcn_exp2f(S[r] - mn); rsum += p[r]; }
    rsum = xhalf_sum(rsum);
    lsum = lsum * alpha + rsum;
    if (__any(alpha != 1.f)) {
#pragma unroll
      for (int i = 0; i < NB; ++i)
#pragma unroll
        for (int r = 0; r < 16; ++r) acc[i][r] *= alpha;
    }
    bf16x8 pf[2];
#pragma unroll
    for (int s2 = 0; s2 < 2; ++s2) {
      unsigned w0 = pack2(p[8 * s2 + 0], p[8 * s2 + 1]), w1 = pack2(p[8 * s2 + 2], p[8 * s2 + 3]);
      unsigned w2 = pack2(p[8 * s2 + 4], p[8 * s2 + 5]), w3 = pack2(p[8 * s2 + 6], p[8 * s2 + 7]);
      uint4 u = {w0, w1, w2, w3};
      pf[s2] = __builtin_bit_cast(bf16x8, u);
    }
#pragma unroll
    for (int i = 0; i < NB; ++i) {
      const int d = i * 32 + ql, f = vswz(d);
      const char* vr = sV + d * 64;
#pragma unroll
      for (int s2 = 0; s2 < 2; ++s2) {
        bf16x8 vf = *(const bf16x8*)(vr + (((2 * s2 + hh) ^ f) << 4));
        acc[i] = MFMA32(vf, pf[s2], acc[i]);
      }
    }
    {
      char* dK = smem + ((it + 1) & 1) * BUF;
      attn_store<DQK, DV>(rk, rv, mp, dK, dK + KB);
    }
    __syncthreads();
  }
  const float inv = 1.f / lsum;
  bf16_t* op = O + (size_t)(b * SB + qs) * ldo;
#pragma unroll
  for (int i = 0; i < NB; ++i)
#pragma unroll
    for (int g = 0; g < 4; ++g) {
      uint2 u = {pack2(acc[i][4 * g] * inv, acc[i][4 * g + 1] * inv), pack2(acc[i][4 * g + 2] * inv, acc[i][4 * g + 3] * inv)};
      *(uint2*)(op + i * 32 + 8 * g + 4 * hh) = u;
    }
}

DI void phase_attn(const Params& P, int l, char* smem) {
  char* Bg = P.ws + OFF_BIG;
  const int nmla_l = 2048, nmla_c = 32, nwa = 2 * 16 * 130;
  const int total = nmla_l + nmla_c + nwa;
  for (int it = bidx(); it < total; it += gdim()) {
    if (l == 1) {
      if (it >= nmla_l && it < nmla_l + nmla_c) continue;
      if (it >= nmla_l + nmla_c && ((it - nmla_l - nmla_c) % 130) < 2) continue;
    }
    if (it < nmla_l + nmla_c) {
      int b, h, sq0, kend;
      if (it < nmla_l) {
        const int j = (it & 7) * (nmla_l >> 3) + (it >> 3);
        int bh = j >> 7, qt = j & 127; b = bh >> 3; h = bh & 7; sq0 = CTXL + 128 * qt; kend = SB;
      }
      else { int i2 = it - nmla_l; int bh = i2 >> 1, qt = i2 & 1; b = bh >> 3; h = bh & 7; sq0 = 128 * qt; kend = CTXL; }
      attn_tile<192, 128>((const bf16_t*)(Bg + B_QMLA) + h * 192, LDKQ, (const bf16_t*)(Bg + B_KMLA) + h * 192, LDKQ,
                          (const bf16_t*)(Bg + B_VTMLA) + ((size_t)b * 1024 + h * 128) * SB, (bf16_t*)(P.ws + OFF_OC) + h * 128, 1024,
                          b, sq0, 0, kend, 0, 0, -1e30f, 0.f, smem);
    } else {
      int i2 = it - nmla_l - nmla_c;
      int bh = i2 / 130, qt = i2 - bh * 130;
      int b = bh >> 4, h = bh & 15, kvh = h >> 2;
      int sq0 = 128 * qt;
      int r1a = 0, r1b = 0;
      if (qt >= 2) {
        r1a = sq0 - 128; if (r1a < CTXL) r1a = CTXL;
        r1b = sq0 + 256; if (r1b > SB) r1b = SB;
      }
      float sink = P.in[22][l * 16 + h] * LOG2E;
      attn_tile<64, 64>((const bf16_t*)(Bg + B_QWA) + h * 64, 1024, (const bf16_t*)(Bg + B_KWA) + kvh * 64, 256,
                        (const bf16_t*)(Bg + B_VTWA) + ((size_t)b * 256 + kvh * 64) * SB, (bf16_t*)(P.ws + OFF_OB) + h * 64, 1024,
                        b, sq0, 0, CTXL, r1a, r1b, sink, 1.f, smem);
    }
  }
}

DI void phase_inproj_att(const Params& P, int l, char* smem) {
  char* W = P.ws + OFF_W; char* Bg = P.ws + OFF_BIG;
  const bf16_t* H = (const bf16_t*)(P.ws + OFF_H);
  const float* cs = (const float*)(P.ws + OFF_SMALL + S_COS);
  const float* sn = (const float*)(P.ws + OFF_SMALL + S_SIN);
  const int nwa = 130 * 12, nml = 130 * 9;
  for (int it = bidx(); it < nwa + nml; it += gdim()) {
    if (it < nwa) {
      EpiWA e{(bf16_t*)(Bg + B_QWA), (bf16_t*)(Bg + B_KWA), (bf16_t*)(Bg + B_VTWA), cs, sn};
      gemm256_item_plain(H, LDH, (const bf16_t*)(W + W_IN) + (size_t)3520 * LDW, LDW, D, 12, smem, e, it);
    } else {
      EpiMLAin e{(bf16_t*)(Bg + B_ZMLA), (float*)(P.ws + OFF_SMALL + S_SSQ)};
      gemm256_item_plain(H, LDH, (const bf16_t*)(W + W_IN) + (size_t)5056 * LDW, LDW, D, 9, smem, e, it - nwa);
    }
  }
}

DI void phase_uproj(const Params& P, int l, char* smem) {
  char* W = P.ws + OFF_W; char* Bg = P.ws + OFF_BIG;
  const bf16_t* Z = (const bf16_t*)(Bg + B_ZMLA);
  const float* cs = (const float*)(P.ws + OFF_SMALL + S_COS);
  const float* sn = (const float*)(P.ws + OFF_SMALL + S_SIN);
  const float* ssq = (const float*)(P.ws + OFF_SMALL + S_SSQ);
  bf16_t* Kd = (bf16_t*)(Bg + B_KMLA);
  for (int idx = bidx() * 256 + tidx(); idx < T * 32; idx += gdim() * 256) {
    int row = idx >> 5, d = idx & 31;
    int b = row / SB, s = row - b * SB;
    float a = bf2f(Z[(size_t)row * 1088 + 1024 + d]), bb = bf2f(Z[(size_t)row * 1088 + 1024 + d + 32]);
    if (s >= CTXL) rope_pair(a, bb, cs, sn, s - CTXL, d);
    bf16_t ua = f2bf(a), ub = f2bf(bb);
#pragma unroll
    for (int h = 0; h < 8; ++h) {
      Kd[(size_t)row * LDKQ + h * 192 + 128 + d] = ua;
      Kd[(size_t)row * LDKQ + h * 192 + 160 + d] = ub;
    }
  }
  const int nq = 130 * 12, nkv = 130 * 16;
  for (int it = bidx(); it < nq + nkv; it += gdim()) {
    if (it < nq) {
      EpiUQ e{(bf16_t*)(Bg + B_QMLA), ssq, cs, sn};
      gemm256_item_plain(Z, 1088, (const bf16_t*)(W + W_UQ), LDUQ, 512, 12, smem, e, it);
    } else {
      EpiUKV e{Kd, (bf16_t*)(Bg + B_VTMLA), ssq};
      gemm256_item_plain(Z + 512, 1088, (const bf16_t*)(W + W_UKV), LDUQ, 512, 16, smem, e, it - nq);
    }
  }
}

DI void phase_merge(const Params& P, char* smem, bool skip_ctx) {
  char* W = P.ws + OFF_W;
  const bf16_t* G = (const bf16_t*)(P.ws + OFF_BIG + B_G);
  bf16_t* Y = (bf16_t*)(P.ws + OFF_H);
  const int tid = tidx(), lane = tid & 63, wid = tid >> 6;
  const int wr = wid >> 1, wc = wid & 1, fr = lane & 15, fq = lane >> 4;
  const int total = 260 * 16;
  for (int it = bidx(); it < total; it += gdim()) {
    int mt = it >> 4, nt = it & 15;
    int b = mt / 130, s0 = (mt - b * 130) * 128, col0 = nt * 128;
    if (skip_ctx && s0 < CTXL) continue;
    f32x4 yacc[4][4];
    zero_acc(yacc);
#pragma unroll 1
    for (int i = 0; i < 3; ++i) {
      f32x4 acc[4][4];
      zero_acc(acc);
      const bf16_t* Oi = (const bf16_t*)(P.ws + (i == 0 ? OFF_OA : (i == 1 ? OFF_OB : OFF_OC)));
      gemm_kloop1(acc, Oi, 1024, (const bf16_t*)(W + W_BR) + (size_t)i * D * LDWB, LDWB, 1024, b, s0, col0, smem);
#pragma unroll
      for (int m = 0; m < 4; ++m)
#pragma unroll
        for (int n = 0; n < 4; ++n)
#pragma unroll
          for (int j = 0; j < 4; ++j) {
            size_t row = (size_t)b * SB + s0 + wr * 64 + m * 16 + fq * 4 + j;
            float gv = bf2f(G[row * 6144 + i * 2048 + col0 + wc * 64 + n * 16 + fr]);
            yacc[m][n][j] += gv * acc[m][n][j];
          }
    }
    float* tile = (float*)smem;
    acc_to_tile(yacc, tile);
    __syncthreads();
    EpiStore e{Y, LDH, D};
    e(tile, b, s0, col0);
    __syncthreads();
  }
}

constexpr int NPHASE = 33;
#ifndef PH_MASK
#define PH_MASK 0xFFFFFFFFu
#endif
#define PH_ON(n) ((PH_MASK >> (n)) & 1u)
DI bool phase_empty(int ph) { return ph == 2 + 3; }

DI void run_phase(const Params& P, int ph, char* smem) {
  if (ph == 0) { if (PH_ON(15)) phase_init(P, smem); return; }
  if (ph == 1) { if (PH_ON(16)) phase_modred(P); return; }
  if (ph == 32) { if (PH_ON(17)) phase_final(P); return; }
  const int l = (ph - 2) / 15, q = (ph - 2) % 15;
  char* W = P.ws + OFF_W; char* Bg = P.ws + OFF_BIG;
  const bf16_t* H = (const bf16_t*)(P.ws + OFF_H);
  switch (q) {
    case 0: if (PH_ON(0)) phase_norm(P, l, 1); break;
    case 1: if (PH_ON(1)) {
      EpiRW e{P.in[8] + (size_t)l * 3520, (bf16_t*)(Bg + B_ZRKV), (bf16_t*)(Bg + B_LORA), l == 0 ? (bf16_t*)(P.ws + OFF_VF) : nullptr};
      gemm256_phase_overlap(H, LDH, (const bf16_t*)(W + W_IN), LDW, D, 28, smem, e);
    } break;
    case 2: if (PH_ON(2)) phase_lora(P, l, smem); break;
    case 3: if (PH_ON(3)) {
      if (l >= 1) {
        EpiVres e{P.in[19] + (size_t)(l - 1) * 1024, (bf16_t*)(Bg + B_ZRKV), (const bf16_t*)(P.ws + OFF_VF)};
        gemm_phase_plain((const bf16_t*)(P.ws + OFF_SMALL + S_TV1), 64, (const bf16_t*)(W + W_V2), 64, 64, 8, smem, e);
      }
    } break;
    case 4: if (PH_ON(4)) phase_scan(P, l, smem); break;
    case 5: if (PH_ON(5)) phase_post(P, l); break;
    case 6: if (PH_ON(6)) phase_inproj_att(P, l, smem); break;
    case 7: if (PH_ON(7)) phase_uproj(P, l, smem); break;
    case 8: if (PH_ON(8)) phase_attn(P, l, smem); break;
    case 9: if (PH_ON(9)) {
      EpiSigBias e{nullptr, (bf16_t*)(Bg + B_G), 6144};
      gemm256_phase_plain(H, LDH, (const bf16_t*)(W + W_IN) + (size_t)6144 * LDW, LDW, D, 48, smem, e, l == 1);
    } break;
    case 10: if (PH_ON(10)) phase_merge(P, smem, l == 1); break;
    case 11: if (PH_ON(11)) {
      EpiResid e{&P, l, 2, l == 0};
      gemm256_phase_plain(H, LDH, (const bf16_t*)(W + W_OUT), LDW, D, 16, smem, e, l == 1);
    } break;
    case 12: if (PH_ON(12)) {
      phase_norm(P, l, 2);
      const int lw = (l + 1 < 2) ? l + 1 : -1;
      const int tot = conv_total(lw, l);
      for (int it = bidx(); it < tot; it += gdim()) run_conv_item(P, lw, l, it, (float*)smem);
    } break;
    case 13: if (PH_ON(13)) {
      EpiFFNin e{P.in[31] + (size_t)l * 3 * 5632, P.in[32] + (size_t)l * 5632, (bf16_t*)(Bg + B_A2)};
      gemm256_phase_overlap(H, LDH, (const bf16_t*)(Bg + B_WFIN), LDW, D, 88, smem, e);
    } break;
    case 14: if (PH_ON(14)) {
      EpiResid e{&P, l, 5, false};
      gemm256_phase_plain((const bf16_t*)(Bg + B_A2), LDA2, (const bf16_t*)(Bg + B_WFOUT), LDA2, 5632, 16, smem, e, l == 1);
    } break;
  }
}

__global__ void __launch_bounds__(256, 2) mega(Params P) {
  __shared__ __attribute__((aligned(16))) char smem[69632];
  const int p0 = P.p0, p1 = P.p1;
  for (int ph = p0; ph < p1; ++ph) {
    if (phase_empty(ph)) continue;
    const __attribute__((address_space(4))) char* kp = (const __attribute__((address_space(4))) char*)__builtin_amdgcn_kernarg_segment_ptr();
    asm volatile("" : "+s"(kp));
    const Params& Pr = *(const Params*)(kp);
    int nrep = 1;
#ifdef REP_MASK
    if (ph >= 2 && ph < 32 && ((REP_MASK >> ((ph - 2) % 15)) & 1)) nrep = 2;
#endif
#pragma unroll 1
    for (int rep = 0; rep < nrep; ++rep) run_phase(Pr, ph, smem);
    if (ph + 1 < p1) cg::this_grid().sync();
  }
}

extern "C" void kernel_launch(void* const* d_in, const int* in_sizes, int n_in, void* d_out, int out_size, void* d_ws,
                              size_t ws_size, hipStream_t stream) {
  static int grid_blocks = 0;
  if (!grid_blocks) {
    int dev = 0, cus = 0, per_cu = 0;
    hipGetDevice(&dev);
    hipDeviceGetAttribute(&cus, hipDeviceAttributeMultiprocessorCount, dev);
    hipOccupancyMaxActiveBlocksPerMultiprocessor(&per_cu, mega, 256, 0);
    if (per_cu < 1) per_cu = 1;
    grid_blocks = cus * per_cu;
  }
  Params p;
  memset(&p, 0, sizeof(p));
  for (int i = 0; i < 35; ++i) p.in[i] = (const float*)d_in[i];
  p.out = (float*)d_out;
  p.ws = (char*)d_ws;
#if ONE_LAUNCH
  p.p0 = 0; p.p1 = NPHASE;
  void* args[] = {&p};
  hipError_t e = hipLaunchCooperativeKernel((void*)mega, dim3(grid_blocks), dim3(256), args, 0, stream);
  if (e != hipSuccess) fprintf(stderr, "cooperative launch failed: %s (grid %d)\n", hipGetErrorString(e), grid_blocks);
#else
  for (int ph = 0; ph < NPHASE; ++ph) {
    if (ph == 2 + 3) continue;
    p.p0 = ph; p.p1 = ph + 1;
    hipLaunchKernelGGL(mega, dim3(grid_blocks), dim3(256), 0, stream, p);
  }
#endif
}
```

```cpp
#include <hip/hip_runtime.h>
#include <hip/hip_bf16.h>
#include <hip/hip_cooperative_groups.h>
#include <cstdio>
#include <cstring>
namespace cg = cooperative_groups;

#ifndef ONE_LAUNCH
#define ONE_LAUNCH 1
#endif

typedef unsigned short bf16_t;
using bf16x8 = __attribute__((ext_vector_type(8))) short;
using f32x4 = __attribute__((ext_vector_type(4))) float;
using f32x16 = __attribute__((ext_vector_type(16))) float;
#define DI __device__ __forceinline__

constexpr int D = 2048, SEQ = 16384, CTXL = 256, SB = 16640, T = 33280;
constexpr int INC = 12288;
constexpr size_t MiB = 1u << 20;
constexpr int LDH = 2112, LDW = 2112, LDWB = 1088, LDUQ = 576, LDA2 = 5696, LDKQ = 1600;
constexpr size_t OFF_W = 0, OFF_SMALL = 78 * MiB, OFF_H = 92 * MiB, OFF_VF = 230 * MiB, OFF_OA = 295 * MiB,
                 OFF_OB = 360 * MiB, OFF_OC = 425 * MiB, OFF_BIG = 490 * MiB;
constexpr size_t W_IN = 0, W_BR = W_IN + (size_t)12288 * LDW * 2, W_OUT = W_BR + (size_t)3 * 2048 * LDWB * 2,
                 W_UQ = W_OUT + (size_t)2048 * LDW * 2, W_UKV = W_UQ + (size_t)1536 * LDUQ * 2,
                 W_W2 = W_UKV + (size_t)2048 * LDUQ * 2, W_A2 = W_W2 + 2 * 1024 * 128 * 2, W_G2 = W_A2 + 2 * 1024 * 128 * 2,
                 W_V1 = W_G2 + 1024 * 64 * 2, W_V2 = W_V1 + 128 * 1024 * 2, W_END = W_V2 + 1024 * 64 * 2;
static_assert(W_END <= 78 * MiB, "W region overflow");
static_assert((size_t)T * LDH * 2 <= (230 - 92) * MiB, "H region overflow");
constexpr size_t S_XC = 0, S_MOD = 4 * MiB, S_COS = 5 * MiB, S_SIN = 7 * MiB, S_SSQ = 9 * MiB, S_TV1 = 9 * MiB + 512 * 1024, S_CNT = 13 * MiB + 768 * 1024;
constexpr size_t B_ZRKV = 0, B_LORA = 195 * MiB, B_EF = 232 * MiB, B_EB = 297 * MiB, B_AF = 362 * MiB, B_AB = 427 * MiB;
constexpr size_t B_QWA = 0, B_KWA = 65 * MiB, B_VTWA = 82 * MiB, B_ZMLA = 99 * MiB, B_QMLA = 169 * MiB,
                 B_KMLA = 271 * MiB, B_VTMLA = 373 * MiB;
static_assert((size_t)T * LDKQ * 2 <= 102 * MiB, "q/k mla overflow");
constexpr size_t B_G = 0, B_A2 = 0, B_WFIN = 362 * MiB, B_WFOUT = 408 * MiB;
static_assert((size_t)T * LDA2 * 2 <= 362 * MiB && (size_t)11264 * LDW * 2 <= 46 * MiB && (size_t)2048 * LDA2 * 2 <= 24 * MiB, "ffn stage overflow");

constexpr float LOG2E = 1.4426950408889634f;
extern "C" __device__ size_t __ockl_get_num_groups(unsigned);
DI int tidx() { int t = __builtin_amdgcn_workitem_id_x(); asm volatile("" : "+v"(t)); return t; }
DI int bidx() { int t = __builtin_amdgcn_workgroup_id_x(); asm volatile("" : "+s"(t)); return t; }
DI int gdim() { int t = (int)__ockl_get_num_groups(0); asm volatile("" : "+s"(t)); return t; }


struct Params {
  const float* in[35];
  float* out;
  char* ws;
  int p0, p1;
};

typedef __bf16 hbf16x2_t __attribute__((ext_vector_type(2)));
typedef float hf32x2_t __attribute__((ext_vector_type(2)));
DI unsigned pack2(float a, float b) {
  hf32x2_t v = {a, b};
  return __builtin_bit_cast(unsigned, __builtin_convertvector(v, hbf16x2_t));
}
DI unsigned short f2bf(float x) { return (unsigned short)(pack2(x, 0.f) & 0xffffu); }
DI float bf2f(unsigned short h) { return __uint_as_float(((unsigned)h) << 16); }
DI float bflo(unsigned u) { return __uint_as_float(u << 16); }
DI float bfhi(unsigned u) { return __uint_as_float(u & 0xffff0000u); }
DI float sigmoidf_(float x) { return __builtin_amdgcn_rcpf(1.f + __expf(-x)); }

template <int CTRL>
DI float dpp_add(float x) {
  int v = __builtin_amdgcn_update_dpp(0, __float_as_int(x), CTRL, 0xF, 0xF, true);
  return x + __int_as_float(v);
}
DI float reduce16(float x) {
  x = dpp_add<0xB1>(x);
  x = dpp_add<0x4E>(x);
  x = dpp_add<0x141>(x);
  x = dpp_add<0x140>(x);
  return x;
}
using u32x4 = __attribute__((ext_vector_type(4))) unsigned;
DI u32x4 gload16(const void* p) { return *(const u32x4*)p; }
typedef __amdgpu_buffer_rsrc_t brsrc_t;
DI brsrc_t make_rsrc(const void* p) { return __builtin_amdgcn_make_buffer_rsrc((void*)p, 0, 0x7fffffff, 0x00020000); }
DI u32x4 bload16(brsrc_t r, unsigned voff, unsigned soff) { return __builtin_amdgcn_raw_buffer_load_b128(r, (int)voff, (int)soff, 0); }
DI void cfence() { asm volatile("" ::: "memory"); }
DI void vm_wait8(u32x4& a, u32x4& b, u32x4& c, u32x4& d, u32x4& e, u32x4& f, u32x4& g, u32x4& h) { cfence(); }
using u32x2 = __attribute__((ext_vector_type(2))) unsigned;
DI u32x2 gload8(const void* p) { return *(const u32x2*)p; }
DI void vm_wait5x2(u32x2& a, u32x2& b, u32x2& c, u32x2& d, u32x2& e) { cfence(); }
DI void vm_wait1(u32x4& a) {}
DI float fma_(float a, float b, float c) { float d; asm("v_fma_f32 %0, %1, %2, %3" : "=v"(d) : "v"(a), "v"(b), "v"(c)); return d; }
DI float mul_(float a, float b) { float d; asm("v_mul_f32 %0, %1, %2" : "=v"(d) : "v"(a), "v"(b)); return d; }
DI float add_(float a, float b) { float d; asm("v_add_f32 %0, %1, %2" : "=v"(d) : "v"(a), "v"(b)); return d; }
DI float sel_mask_(float keep, float take, unsigned long long mask) {
  float d;
  asm("v_cndmask_b32 %0, %1, %2, %3" : "=v"(d) : "v"(keep), "v"(take), "s"(mask));
  return d;
}
DI float add_n_(float a, float b) { float d; asm("v_add_f32 %0, %1, %2\n\ts_nop 1" : "=v"(d) : "v"(a), "v"(b)); return d; }
DI float fma_n_(float a, float b, float c) { float d; asm("v_fma_f32 %0, %1, %2, %3\n\ts_nop 1" : "=v"(d) : "v"(a), "v"(b), "v"(c)); return d; }
DI float xhalf_max(float x) {
  auto r = __builtin_amdgcn_permlane32_swap(__float_as_uint(x), __float_as_uint(x), false, false);
  return fmaxf(__uint_as_float(r[0]), __uint_as_float(r[1]));
}
DI float xhalf_sum(float x) {
  auto r = __builtin_amdgcn_permlane32_swap(__float_as_uint(x), __float_as_uint(x), false, false);
  return __uint_as_float(r[0]) + __uint_as_float(r[1]);
}
DI float wave_sum(float x) {
  x = reduce16(x);
  auto r = __builtin_amdgcn_permlane16_swap(__float_as_uint(x), __float_as_uint(x), false, false);
  x = __uint_as_float(r[0]) + __uint_as_float(r[1]);
  return xhalf_sum(x);
}

DI float* xrow(const Params& P, int row) {
  int b = row / SB, s = row - b * SB;
  if (s < CTXL) return (float*)(P.ws + OFF_SMALL + S_XC) + ((size_t)(b * CTXL + s)) * D;
  return P.out + ((size_t)b * SEQ + (s - CTXL)) * D;
}
DI const float* xrow_in(const Params& P, int row) {
  int b = row / SB, s = row - b * SB;
  if (s < CTXL) return P.in[2] + ((size_t)(b * CTXL + s)) * D;
  return P.in[0] + ((size_t)b * SEQ + (s - CTXL)) * D;
}
DI const float* modvec(const Params& P, int l, int b, int s, int chunk) {
  int vec = (s < CTXL) ? 2 : b;
  return (const float*)(P.ws + OFF_SMALL + S_MOD) + ((size_t)(l * 3 + vec) * INC) + chunk * D;
}

constexpr int TS = 132;
#define MFMA16(a, b, c) __builtin_amdgcn_mfma_f32_16x16x32_bf16((a), (b), (c), 0, 0, 0)
#define MFMA32(a, b, c) __builtin_amdgcn_mfma_f32_32x32x16_bf16((a), (b), (c), 0, 0, 0)

DI void gemm_compute(f32x4 (&acc)[4][4], const char* cA, const char* cB, int fq, int sw) {
  bf16x8 af[2][4], bfr[2][4];
#pragma unroll
  for (int kk = 0; kk < 2; ++kk) {
    const int co = (((kk * 4 + fq) ^ sw) << 4);
#pragma unroll
    for (int m = 0; m < 4; ++m) af[kk][m] = *(const bf16x8*)(cA + m * 2048 + co);
#pragma unroll
    for (int n = 0; n < 4; ++n) bfr[kk][n] = *(const bf16x8*)(cB + n * 2048 + co);
  }
  __builtin_amdgcn_sched_barrier(0);
#pragma unroll
  for (int kk = 0; kk < 2; ++kk)
#pragma unroll
    for (int m = 0; m < 4; ++m)
#pragma unroll
      for (int n = 0; n < 4; ++n) acc[m][n] = MFMA16(af[kk][m], bfr[kk][n], acc[m][n]);
}

DI void gemm_kloop(f32x4 (&acc)[4][4], const bf16_t* __restrict__ A, int lda, const bf16_t* __restrict__ Bt, int ldb,
                   int K, int b, int s0, int col0, char* smem) {
  const int tid = tidx(), lane = tid & 63, wid = tid >> 6;
  const int wr = wid >> 1, wc = wid & 1, fr = lane & 15, fq = lane >> 4;
  const int lrow = tid >> 3, lkc = tid & 7;
  const bf16_t* ap[4];
#pragma unroll
  for (int j = 0; j < 4; ++j) {
    int s = s0 + lrow + 32 * j;
    s = s < 0 ? 0 : (s > SB - 1 ? SB - 1 : s);
    ap[j] = A + (size_t)(b * SB + s) * lda + lkc * 8;
  }
  const bf16_t* bp = Bt + (size_t)(col0 + lrow) * ldb + lkc * 8;
  const size_t bstep = (size_t)32 * ldb;
  const int wofs = lrow * 128 + ((lkc ^ ((lrow >> 1) & 7)) << 4);
  char* sA = smem;
  char* sB = smem + 32768;
  const int nk = K >> 6;
  u32x4 xa[4], xb[4], ya[4], yb[4];
#define GLOAD(RA, RB, KT)                                        \
  {                                                              \
    const int kn_ = ((KT) < nk) ? (KT) : nk - 1;                 \
    _Pragma("unroll") for (int j = 0; j < 4; ++j) {              \
      RA[j] = gload16(ap[j] + kn_ * 64);                         \
      RB[j] = gload16(bp + j * bstep + kn_ * 64);                \
    }                                                            \
  }
#define LSTORE(RA, RB, P)                                        \
  {                                                              \
    char* dA_ = sA + (P) * 16384 + wofs;                         \
    char* dB_ = sB + (P) * 16384 + wofs;                         \
    _Pragma("unroll") for (int j = 0; j < 4; ++j) {              \
      *(u32x4*)(dA_ + j * 4096) = RA[j];                         \
      *(u32x4*)(dB_ + j * 4096) = RB[j];                         \
    }                                                            \
  }
  GLOAD(xa, xb, 0);
  GLOAD(ya, yb, 1);
  cfence();
  LSTORE(xa, xb, 0);
  __syncthreads();
  const int aofs = (wr * 64 + fr) * 128, bofs = (wc * 64 + fr) * 128, sw = (fr >> 1) & 7;
  for (int kt = 0; kt < nk; kt += 2) {
    GLOAD(xa, xb, kt + 2);
    cfence();
    gemm_compute(acc, sA + aofs, sB + bofs, fq, sw);
    LSTORE(ya, yb, 1);
    __syncthreads();
    if (kt + 1 < nk) {
      GLOAD(ya, yb, kt + 3);
      cfence();
      gemm_compute(acc, sA + 16384 + aofs, sB + 16384 + bofs, fq, sw);
      LSTORE(xa, xb, 0);
      __syncthreads();
    }
  }
#undef GLOAD
#undef LSTORE
}

DI void gemm_kloop1(f32x4 (&acc)[4][4], const bf16_t* __restrict__ A, int lda, const bf16_t* __restrict__ Bt, int ldb,
                   int K, int b, int s0, int col0, char* smem) {
  const int tid = tidx(), lane = tid & 63, wid = tid >> 6;
  const int wr = wid >> 1, wc = wid & 1, fr = lane & 15, fq = lane >> 4;
  const int lrow = tid >> 3, lkc = tid & 7;
  const brsrc_t rA = make_rsrc(A), rB = make_rsrc(Bt);
  unsigned aoff[4];
#pragma unroll
  for (int j = 0; j < 4; ++j) {
    int s = s0 + lrow + 32 * j;
    s = s < 0 ? 0 : (s > SB - 1 ? SB - 1 : s);
    aoff[j] = ((unsigned)(b * SB + s) * (unsigned)lda + lkc * 8) * 2u;
  }
  const unsigned boff = ((unsigned)(col0 + lrow) * (unsigned)ldb + lkc * 8) * 2u;
  const unsigned bstep = 32u * (unsigned)ldb * 2u;
  const int wofs = lrow * 128 + ((lkc ^ ((lrow >> 1) & 7)) << 4);
  char* sA = smem;
  char* sB = smem + 32768;
  const int nk = K >> 6;
  u32x4 ra[4], rb[4];
#pragma unroll
  for (int j = 0; j < 4; ++j) {
    ra[j] = bload16(rA, aoff[j], 0u);
    rb[j] = bload16(rB, boff + j * bstep, 0u);
  }
  vm_wait8(ra[0], ra[1], ra[2], ra[3], rb[0], rb[1], rb[2], rb[3]);
#pragma unroll
  for (int j = 0; j < 4; ++j) {
    *(u32x4*)(sA + wofs + j * 4096) = ra[j];
    *(u32x4*)(sB + wofs + j * 4096) = rb[j];
  }
  __syncthreads();
  const int aofs = (wr * 64 + fr) * 128, bofs = (wc * 64 + fr) * 128, sw = (fr >> 1) & 7;
  for (int kt = 0; kt < nk; ++kt) {
    const int p = kt & 1;
    {
      const int kn = (kt + 1 < nk) ? kt + 1 : kt;
#pragma unroll
      for (int j = 0; j < 4; ++j) {
        ra[j] = bload16(rA, aoff[j], (unsigned)kn * 128u);
        rb[j] = bload16(rB, boff + j * bstep, (unsigned)kn * 128u);
      }
    }
    cfence();
    const char* cA = sA + p * 16384 + aofs;
    const char* cB = sB + p * 16384 + bofs;
#pragma unroll
    for (int kk = 0; kk < 2; ++kk) {
      bf16x8 af[4], bfr[4];
      const int co = (((kk * 4 + fq) ^ sw) << 4);
#pragma unroll
      for (int m = 0; m < 4; ++m) af[m] = *(const bf16x8*)(cA + m * 2048 + co);
#pragma unroll
      for (int n = 0; n < 4; ++n) bfr[n] = *(const bf16x8*)(cB + n * 2048 + co);
#pragma unroll
      for (int m = 0; m < 4; ++m)
#pragma unroll
        for (int n = 0; n < 4; ++n) acc[m][n] = MFMA16(af[m], bfr[n], acc[m][n]);
    }
    {
      char* dA = sA + (p ^ 1) * 16384 + wofs;
      char* dB = sB + (p ^ 1) * 16384 + wofs;
      vm_wait8(ra[0], ra[1], ra[2], ra[3], rb[0], rb[1], rb[2], rb[3]);
#pragma unroll
      for (int j = 0; j < 4; ++j) {
        *(u32x4*)(dA + j * 4096) = ra[j];
        *(u32x4*)(dB + j * 4096) = rb[j];
      }
    }
    __syncthreads();
  }
}

DI void zero_acc(f32x4 (&acc)[4][4]) {
#pragma unroll
  for (int m = 0; m < 4; ++m)
#pragma unroll
    for (int n = 0; n < 4; ++n) acc[m][n] = f32x4{0.f, 0.f, 0.f, 0.f};
}

DI void acc_to_tile(const f32x4 (&acc)[4][4], float* tile) {
  const int tid = tidx(), lane = tid & 63, wid = tid >> 6;
  const int wr = wid >> 1, wc = wid & 1, fr = lane & 15, fq = lane >> 4;
#pragma unroll
  for (int m = 0; m < 4; ++m)
#pragma unroll
    for (int n = 0; n < 4; ++n)
#pragma unroll
      for (int j = 0; j < 4; ++j) tile[(wr * 64 + m * 16 + fq * 4 + j) * TS + wc * 64 + n * 16 + fr] = acc[m][n][j];
}

DI int swz4(int row) { const int g = (row >> 2) & 3; return ((g << 1) ^ ((g >> 1) * 3)) & 3; }
DI void gemm256_kloop(f32x4 (&acc)[8][4], const bf16_t* __restrict__ A, int lda, const bf16_t* __restrict__ Bt, int ldb,
                      int K, int b, int s0, int col0, char* smem) {
  const int tid = tidx(), lane = tid & 63, wid = tid >> 6;
  const int wr = wid >> 1, wc = wid & 1, fr = lane & 15, fq = lane >> 4;
  const int lrow = tid >> 2, lkc = tid & 3;
  const brsrc_t rA = make_rsrc(A), rB = make_rsrc(Bt);
  unsigned aoff[4];
#pragma unroll
  for (int j = 0; j < 4; ++j) {
    int s = s0 + lrow + 64 * j;
    s = s < 0 ? 0 : (s > SB - 1 ? SB - 1 : s);
    aoff[j] = ((unsigned)(b * SB + s) * (unsigned)lda + lkc * 8) * 2u;
  }
  const unsigned boff = ((unsigned)(col0 + lrow) * (unsigned)ldb + lkc * 8) * 2u;
  const unsigned bstep = 64u * (unsigned)ldb * 2u;
  const int wofs = lrow * 64 + ((lkc ^ swz4(lrow)) << 4);
  const int nk = K >> 5;
  u32x4 xa[4], xb[2], ya[4], yb[2];
#define GLOAD2(RA, RB, KT)                                       \
  {                                                              \
    const int kn_ = ((KT) < nk) ? (KT) : nk - 1;                 \
    _Pragma("unroll") for (int j = 0; j < 4; ++j) RA[j] = bload16(rA, aoff[j], (unsigned)kn_ * 64u); \
    _Pragma("unroll") for (int j = 0; j < 2; ++j) RB[j] = bload16(rB, boff + j * bstep, (unsigned)kn_ * 64u); \
  }
#define LSTORE2(RA, RB, P)                                       \
  {                                                              \
    char* dA_ = smem + (P) * 24576 + wofs;                       \
    _Pragma("unroll") for (int j = 0; j < 4; ++j) *(u32x4*)(dA_ + j * 4096) = RA[j]; \
    _Pragma("unroll") for (int j = 0; j < 2; ++j) *(u32x4*)(dA_ + 16384 + j * 4096) = RB[j]; \
  }
#define COMPUTE2(P)                                              \
  {                                                              \
    const char* cA_ = smem + (P) * 24576 + aofs;                 \
    const char* cB_ = smem + (P) * 24576 + 16384 + bofs;         \
    bf16x8 af_[8], bf_[4];                                       \
    _Pragma("unroll") for (int m = 0; m < 8; ++m) af_[m] = *(const bf16x8*)(cA_ + m * 1024); \
    _Pragma("unroll") for (int n = 0; n < 4; ++n) bf_[n] = *(const bf16x8*)(cB_ + n * 1024); \
    __builtin_amdgcn_s_setprio(1);                               \
    _Pragma("unroll") for (int m = 0; m < 8; ++m)                \
      _Pragma("unroll") for (int n = 0; n < 4; ++n) acc[m][n] = MFMA16(af_[m], bf_[n], acc[m][n]); \
    __builtin_amdgcn_s_setprio(0);                               \
  }
  GLOAD2(xa, xb, 0);
  GLOAD2(ya, yb, 1);
  cfence();
  LSTORE2(xa, xb, 0);
  __syncthreads();
  const int co = ((fq ^ swz4(fr)) << 4);
  const int aofs = (wr * 128 + fr) * 64 + co, bofs = (wc * 64 + fr) * 64 + co;
  for (int kt = 0; kt < nk; kt += 2) {
    GLOAD2(xa, xb, kt + 2);
    cfence();
    COMPUTE2(0);
    LSTORE2(ya, yb, 1);
    __syncthreads();
    if (kt + 1 < nk) {
      GLOAD2(ya, yb, kt + 3);
      cfence();
      COMPUTE2(1);
      LSTORE2(xa, xb, 0);
      __syncthreads();
    }
  }
#undef GLOAD2
#undef LSTORE2
#undef COMPUTE2
}

DI void acc256_to_tile(const f32x4 (&acc)[8][4], float* tile, int rowoff) {
  const int tid = tidx(), lane = tid & 63, wid = tid >> 6;
  const int wr = wid >> 1, wc = wid & 1, fr = lane & 15, fq = lane >> 4;
#pragma unroll
  for (int m = 0; m < 8; ++m) {
    const int i0 = wr * 128 + m * 16 + fq * 4 - rowoff;
#pragma unroll
    for (int j = 0; j < 4; ++j) {
      const int i = i0 + j;
      if (i >= 0 && i < 128) {
#pragma unroll
        for (int n = 0; n < 4; ++n) tile[i * TS + wc * 64 + n * 16 + fr] = acc[m][n][j];
      }
    }
  }
}

template <class Epi>
DI void gemm256_tile(const bf16_t* A, int lda, const bf16_t* Bt, int ldb, int K, int b, int s0, int col0, char* smem,
                     const Epi& epi, int rstep) {
  f32x4 acc[8][4];
#pragma unroll
  for (int m = 0; m < 8; ++m)
#pragma unroll
    for (int n = 0; n < 4; ++n) acc[m][n] = f32x4{0.f, 0.f, 0.f, 0.f};
  gemm256_kloop(acc, A, lda, Bt, ldb, K, b, s0, col0, smem);
  float* tile = (float*)smem;
#pragma unroll 1
  for (int pass = 0; pass < 2; ++pass) {
    acc256_to_tile(acc, tile, pass * rstep);
    __syncthreads();
    epi(tile, b, s0 + pass * rstep, col0);
    __syncthreads();
  }
}
template <class Epi>
DI void gemm256_item_plain(const bf16_t* A, int lda, const bf16_t* Bt, int ldb, int K, int ntn, char* smem, const Epi& epi, int it) {
  int mt = it / ntn, nt = it - mt * ntn;
  int b = mt / 65, s0 = (mt - b * 65) * 256;
  gemm256_tile(A, lda, Bt, ldb, K, b, s0, nt * 128, smem, epi, 128);
}
template <class Epi>
DI void gemm256_phase_plain(const bf16_t* A, int lda, const bf16_t* Bt, int ldb, int K, int ntn, char* smem, const Epi& epi,
                            bool skip_ctx = false) {
  if (!skip_ctx) {
    const int total = 130 * ntn;
    for (int it = bidx(); it < total; it += gdim()) gemm256_item_plain(A, lda, Bt, ldb, K, ntn, smem, epi, it);
  } else {
    const int total = 128 * ntn;
    for (int it = bidx(); it < total; it += gdim()) {
      const int mt = it / ntn, nt = it - mt * ntn;
      const int mt2 = mt + 1 + (mt >= 64 ? 1 : 0);
      gemm256_item_plain(A, lda, Bt, ldb, K, ntn, smem, epi, mt2 * ntn + nt);
    }
  }
}
template <class Epi>
DI void gemm256_phase_overlap(const bf16_t* A, int lda, const bf16_t* Bt, int ldb, int K, int ntn, char* smem, const Epi& epi) {
  const int total = 134 * ntn;
  for (int it = bidx(); it < total; it += gdim()) {
    int mt = it / ntn, nt = it - mt * ntn;
    int b = mt / 67, s0 = (mt - b * 67) * 252 - 1;
    gemm256_tile(A, lda, Bt, ldb, K, b, s0, nt * 128, smem, epi, 126);
  }
}

template <class Epi>
DI void gemm_tile(const bf16_t* A, int lda, const bf16_t* Bt, int ldb, int K, int b, int s0, int col0, char* smem,
                  const Epi& epi) {
  f32x4 acc[4][4];
  zero_acc(acc);
  gemm_kloop(acc, A, lda, Bt, ldb, K, b, s0, col0, smem);
  float* tile = (float*)smem;
  acc_to_tile(acc, tile);
  __syncthreads();
  epi(tile, b, s0, col0);
  __syncthreads();
}

DI bool same_dom(int s1, int s2) { return (s1 >= 0) && (s1 < SB) && (s2 >= 0) && (s2 < SB) && ((s1 < CTXL) == (s2 < CTXL)); }

struct EpiStore {
  bf16_t* dst; int ldd; int ncols;
  DI void operator()(const float* tile, int b, int s0, int col0) const {
    const int t = tidx(), c8 = (t & 15) * 8;
    const int n = col0 + c8;
    if (n >= ncols) return;
    for (int i = t >> 4; i < 128; i += 16) {
      size_t row = (size_t)b * SB + s0 + i;
      const float4 a = *(const float4*)(tile + i * TS + c8), c = *(const float4*)(tile + i * TS + c8 + 4);
      *(uint4*)(dst + row * ldd + n) = uint4{pack2(a.x, a.y), pack2(a.z, a.w), pack2(c.x, c.y), pack2(c.z, c.w)};
    }
  }
};

struct EpiRW {
  const float* mu; bf16_t* zrkv; bf16_t* lora; bf16_t* vf;
  DI void operator()(const float* tile, int b, int s0, int col0) const {
    if (col0 < 3072) {
      const int t = tidx(), c8 = (t & 15) * 8, n = col0 + c8;
      float m8[8];
      *(float4*)(m8) = *(const float4*)(mu + n); *(float4*)(m8 + 4) = *(const float4*)(mu + n + 4);
      for (int i = 1 + (t >> 4); i <= 126; i += 16) {
        const int s = s0 + i;
        if (s >= SB) break;
        const float* tr = tile + i * TS + c8;
        const bool hm = same_dom(s - 1, s), hp = same_dom(s + 1, s);
        float z[8], zm[8], zp[8];
        *(float4*)(z) = *(const float4*)(tr); *(float4*)(z + 4) = *(const float4*)(tr + 4);
        *(float4*)(zm) = *(const float4*)(tr - TS); *(float4*)(zm + 4) = *(const float4*)(tr - TS + 4);
        *(float4*)(zp) = *(const float4*)(tr + TS); *(float4*)(zp + 4) = *(const float4*)(tr + TS + 4);
        float o[8];
#pragma unroll
        for (int e = 0; e < 8; ++e) {
          const float nb = (hm ? zm[e] : 0.f) + (hp ? zp[e] : 0.f);
          o[e] = z[e] + m8[e] * (0.5f * nb - z[e]);
        }
        const size_t row = (size_t)b * SB + s;
        const uint4 pk = uint4{pack2(o[0], o[1]), pack2(o[2], o[3]), pack2(o[4], o[5]), pack2(o[6], o[7])};
        *(uint4*)(zrkv + row * 3072 + n) = pk;
        if (vf != nullptr && n >= 2048) *(uint4*)(vf + row * 1024 + (n - 2048)) = pk;
      }
      return;
    }
    const int t = tidx(), c2 = (t & 63) * 2;
    const int n = col0 + c2;
    if (n >= 3520) return;
    const float mu0 = mu[n], mu1 = mu[n + 1];
    for (int i = 1 + (t >> 6); i <= 126; i += 4) {
      const int s = s0 + i;
      if (s >= SB) break;
      const float* tr = tile + i * TS + c2;
      float z0 = tr[0], z1 = tr[1];
      float m0 = 0.f, m1 = 0.f, p0 = 0.f, p1 = 0.f;
      if (same_dom(s - 1, s)) { m0 = tr[-TS]; m1 = tr[-TS + 1]; }
      if (same_dom(s + 1, s)) { p0 = tr[TS]; p1 = tr[TS + 1]; }
      z0 = z0 + mu0 * (0.5f * (m0 + p0) - z0);
      z1 = z1 + mu1 * (0.5f * (m1 + p1) - z1);
      const size_t row = (size_t)b * SB + s;
      if (n < 3072) {
        unsigned pk = pack2(z0, z1);
        *(unsigned*)(zrkv + row * 3072 + n) = pk;
        if (vf != nullptr && n >= 2048) *(unsigned*)(vf + row * 1024 + (n - 2048)) = pk;
      } else if (n < 3456) {
        const int j = (n - 3072) / 96, kk = (n - 3072) - j * 96;
        if (j < 2) { z0 = 2.f * sigmoidf_(2.f * z0) - 1.f; z1 = 2.f * sigmoidf_(2.f * z1) - 1.f; }
        *(unsigned*)(lora + row * 576 + j * 128 + kk) = pack2(z0, z1);
        if (kk < 32) *(unsigned*)(lora + row * 576 + j * 128 + 96 + kk) = 0u;
      } else {
        *(unsigned*)(lora + row * 576 + 512 + (n - 3456)) = pack2(sigmoidf_(z0), sigmoidf_(z1));
      }
    }
  }
};

struct EpiDecay {
  const float* w0; bf16_t* dst;
  DI void operator()(const float* tile, int b, int s0, int col0) const {
    const int t = tidx(), c8 = (t & 15) * 8, n = col0 + c8;
    const float4 ba = *(const float4*)(w0 + n), bc = *(const float4*)(w0 + n + 4);
    const float k = 0.6065306597126334f;
    for (int i = t >> 4; i < 128; i += 16) {
      size_t row = (size_t)b * SB + s0 + i;
      const float4 a = *(const float4*)(tile + i * TS + c8), c = *(const float4*)(tile + i * TS + c8 + 4);
      *(uint4*)(dst + row * 1024 + n) =
          uint4{pack2(k * sigmoidf_(ba.x + a.x), k * sigmoidf_(ba.y + a.y)), pack2(k * sigmoidf_(ba.z + a.z), k * sigmoidf_(ba.w + a.w)),
                pack2(k * sigmoidf_(bc.x + c.x), k * sigmoidf_(bc.y + c.y)), pack2(k * sigmoidf_(bc.z + c.z), k * sigmoidf_(bc.w + c.w))};
    }
  }
};
struct EpiSigBias {
  const float* bias; bf16_t* dst; int ldd;
  DI void operator()(const float* tile, int b, int s0, int col0) const {
    const int t = tidx(), c8 = (t & 15) * 8, n = col0 + c8;
    float4 ba = {0.f, 0.f, 0.f, 0.f}, bc = {0.f, 0.f, 0.f, 0.f};
    if (bias) { ba = *(const float4*)(bias + n); bc = *(const float4*)(bias + n + 4); }
    for (int i = t >> 4; i < 128; i += 16) {
      size_t row = (size_t)b * SB + s0 + i;
      const float4 a = *(const float4*)(tile + i * TS + c8), c = *(const float4*)(tile + i * TS + c8 + 4);
      *(uint4*)(dst + row * ldd + n) =
          uint4{pack2(sigmoidf_(ba.x + a.x), sigmoidf_(ba.y + a.y)), pack2(sigmoidf_(ba.z + a.z), sigmoidf_(ba.w + a.w)),
                pack2(sigmoidf_(bc.x + c.x), sigmoidf_(bc.y + c.y)), pack2(sigmoidf_(bc.z + c.z), sigmoidf_(bc.w + c.w))};
    }
  }
};
struct EpiVres {
  const float* v0; bf16_t* zrkv; const bf16_t* vf;
  DI void operator()(const float* tile, int b, int s0, int col0) const {
    const int t = tidx(), c2 = (t & 63) * 2, n = col0 + c2;
    const float b0 = v0[n], b1 = v0[n + 1];
    for (int i = t >> 6; i < 128; i += 4) {
      size_t row = (size_t)b * SB + s0 + i;
      unsigned* pv = (unsigned*)(zrkv + row * 3072 + 2048 + n);
      unsigned uv = *pv, uf = *(const unsigned*)(vf + row * 1024 + n);
      float va = bflo(uv), vb = bfhi(uv), fa = bflo(uf), fb = bfhi(uf);
      va = va + (fa - va) * sigmoidf_(b0 + tile[i * TS + c2]);
      vb = vb + (fb - vb) * sigmoidf_(b1 + tile[i * TS + c2 + 1]);
      *pv = pack2(va, vb);
    }
  }
};

DI void rope_pair(float& a, float& bb, const float* cs, const float* sn, int t, int d) {
  float c = cs[t * 32 + d], s = sn[t * 32 + d];
  float x = a * c - bb * s, y = a * s + bb * c;
  a = x; bb = y;
}

struct EpiWA {
  bf16_t* q; bf16_t* k; bf16_t* vt; const float* cs; const float* sn;
  DI void operator()(const float* tile, int b, int s0, int col0) const {
    const int t = tidx();
    if (col0 < 1280) {
      const int g = t & 7, hb = g >> 2, d0 = (g & 3) * 8;
      const float scl = (col0 < 1024) ? 0.125f * LOG2E : 1.f;
      for (int i = t >> 3; i < 128; i += 32) {
        const int s = s0 + i;
        float a[8], bb[8];
        const float* tr = tile + i * TS + hb * 64 + d0;
        *(float4*)(a) = *(const float4*)(tr); *(float4*)(a + 4) = *(const float4*)(tr + 4);
        *(float4*)(bb) = *(const float4*)(tr + 32); *(float4*)(bb + 4) = *(const float4*)(tr + 36);
        if (s >= CTXL) {
          float c8[8], s8[8];
          const float* cp = cs + (s - CTXL) * 32 + d0; const float* sp = sn + (s - CTXL) * 32 + d0;
          *(float4*)(c8) = *(const float4*)(cp); *(float4*)(c8 + 4) = *(const float4*)(cp + 4);
          *(float4*)(s8) = *(const float4*)(sp); *(float4*)(s8 + 4) = *(const float4*)(sp + 4);
#pragma unroll
          for (int e = 0; e < 8; ++e) { const float x = a[e] * c8[e] - bb[e] * s8[e], y = a[e] * s8[e] + bb[e] * c8[e]; a[e] = x; bb[e] = y; }
        }
        size_t row = (size_t)b * SB + s;
        bf16_t* dst = (col0 < 1024) ? (q + row * 1024 + col0 + hb * 64) : (k + row * 256 + (col0 - 1024) + hb * 64);
        *(uint4*)(dst + d0) = uint4{pack2(a[0] * scl, a[1] * scl), pack2(a[2] * scl, a[3] * scl), pack2(a[4] * scl, a[5] * scl), pack2(a[6] * scl, a[7] * scl)};
        *(uint4*)(dst + d0 + 32) = uint4{pack2(bb[0] * scl, bb[1] * scl), pack2(bb[2] * scl, bb[3] * scl), pack2(bb[4] * scl, bb[5] * scl), pack2(bb[6] * scl, bb[7] * scl)};
      }
    } else {
      const int c = t >> 1, half = t & 1;
      bf16_t* dst = vt + ((size_t)b * 256 + (col0 - 1280) + c) * SB + s0 + half * 64;
      for (int g = 0; g < 8; ++g) {
        unsigned w[4];
#pragma unroll
        for (int e = 0; e < 4; ++e) {
          int i = half * 64 + g * 8 + e * 2;
          w[e] = pack2(tile[i * TS + c], tile[(i + 1) * TS + c]);
        }
        *(uint4*)(dst + g * 8) = uint4{w[0], w[1], w[2], w[3]};
      }
    }
  }
};

struct EpiMLAin {
  bf16_t* z; float* ssq;
  DI void operator()(const float* tile, int b, int s0, int col0) const {
    const int t = tidx(), c8 = (t & 15) * 8;
    const int n = col0 + c8;
    const int seg = col0 >> 9;
    for (int i = t >> 4; i < 128; i += 16) {
      size_t row = (size_t)b * SB + s0 + i;
      const float4 a = *(const float4*)(tile + i * TS + c8), c = *(const float4*)(tile + i * TS + c8 + 4);
      if (n < 1088) *(uint4*)(z + row * 1088 + n) = uint4{pack2(a.x, a.y), pack2(a.z, a.w), pack2(c.x, c.y), pack2(c.z, c.w)};
      if (seg < 2) {
        float ss = a.x * a.x + a.y * a.y + a.z * a.z + a.w * a.w + c.x * c.x + c.y * c.y + c.z * c.z + c.w * c.w;
        ss = reduce16(ss);
        if ((t & 15) == 0) atomicAdd(ssq + row * 2 + seg, ss);
      }
    }
  }
};

struct EpiUQ {
  bf16_t* q; const float* ssq; const float* cs; const float* sn;
  DI void operator()(const float* tile, int b, int s0, int col0) const {
    const int t = tidx(), g = t & 7, hb = g >> 2, d0 = (g & 3) * 8;
    const int blk64 = (col0 >> 6) + hb;
    const bool roped = (blk64 % 3) == 2;
    const float scl = 0.07216878364870322f * LOG2E;
    for (int i = t >> 3; i < 128; i += 32) {
      const int s = s0 + i;
      size_t row = (size_t)b * SB + s;
      const float rs = rsqrtf(ssq[row * 2] * (1.f / 512.f) + 1e-6f) * scl;
      float a[8], bb[8];
      const float* tr = tile + i * TS + hb * 64 + d0;
      *(float4*)(a) = *(const float4*)(tr); *(float4*)(a + 4) = *(const float4*)(tr + 4);
      *(float4*)(bb) = *(const float4*)(tr + 32); *(float4*)(bb + 4) = *(const float4*)(tr + 36);
      if (roped && s >= CTXL) {
        float c8[8], s8[8];
        const float* cp = cs + (s - CTXL) * 32 + d0; const float* sp = sn + (s - CTXL) * 32 + d0;
        *(float4*)(c8) = *(const float4*)(cp); *(float4*)(c8 + 4) = *(const float4*)(cp + 4);
        *(float4*)(s8) = *(const float4*)(sp); *(float4*)(s8 + 4) = *(const float4*)(sp + 4);
#pragma unroll
        for (int e = 0; e < 8; ++e) { const float x = a[e] * c8[e] - bb[e] * s8[e], y = a[e] * s8[e] + bb[e] * c8[e]; a[e] = x; bb[e] = y; }
      }
      bf16_t* dst = q + row * LDKQ + col0 + hb * 64;
      *(uint4*)(dst + d0) = uint4{pack2(a[0] * rs, a[1] * rs), pack2(a[2] * rs, a[3] * rs), pack2(a[4] * rs, a[5] * rs), pack2(a[6] * rs, a[7] * rs)};
      *(uint4*)(dst + d0 + 32) = uint4{pack2(bb[0] * rs, bb[1] * rs), pack2(bb[2] * rs, bb[3] * rs), pack2(bb[4] * rs, bb[5] * rs), pack2(bb[6] * rs, bb[7] * rs)};
    }
  }
};

struct EpiUKV {
  bf16_t* k; bf16_t* vt; const float* ssq;
  DI void operator()(const float* tile, int b, int s0, int col0) const {
    const int t = tidx();
    const int h = col0 >> 8;
    if (((col0 >> 7) & 1) == 0) {
      const int c8 = (t & 15) * 8;
      for (int i = t >> 4; i < 128; i += 16) {
        size_t row = (size_t)b * SB + s0 + i;
        float rs = rsqrtf(ssq[row * 2 + 1] * (1.f / 512.f) + 1e-6f);
        const float4 a = *(const float4*)(tile + i * TS + c8), c = *(const float4*)(tile + i * TS + c8 + 4);
        *(uint4*)(k + row * LDKQ + h * 192 + c8) =
            uint4{pack2(a.x * rs, a.y * rs), pack2(a.z * rs, a.w * rs), pack2(c.x * rs, c.y * rs), pack2(c.z * rs, c.w * rs)};
      }
    } else {
      const int c = t >> 1, half = t & 1;
      bf16_t* dst = vt + ((size_t)b * 1024 + h * 128 + c) * SB + s0 + half * 64;
      for (int g = 0; g < 8; ++g) {
        unsigned w[4];
#pragma unroll
        for (int e = 0; e < 4; ++e) {
          int i = half * 64 + g * 8 + e * 2;
          size_t row = (size_t)b * SB + s0 + i;
          float rs0 = rsqrtf(ssq[row * 2 + 1] * (1.f / 512.f) + 1e-6f);
          float rs1 = rsqrtf(ssq[(row + 1) * 2 + 1] * (1.f / 512.f) + 1e-6f);
          w[e] = pack2(tile[i * TS + c] * rs0, tile[(i + 1) * TS + c] * rs1);
        }
        *(uint4*)(dst + g * 8) = uint4{w[0], w[1], w[2], w[3]};
      }
    }
  }
};

struct EpiResid {
  const Params* P; int l; int chunk; bool from_input;
  DI void operator()(const float* tile, int b, int s0, int col0) const {
    const int t = tidx(), c4 = (t & 31) * 4, n = col0 + c4;
    for (int i = t >> 5; i < 128; i += 8) {
      const int s = s0 + i;
      const int row = b * SB + s;
      const float* mv = modvec(*P, l, b, s, chunk);
      const float* src = from_input ? xrow_in(*P, row) : xrow(*P, row);
      float* dst = xrow(*P, row);
      const float4 xs = *(const float4*)(src + n), m4 = *(const float4*)(mv + n), a = *(const float4*)(tile + i * TS + c4);
      *(float4*)(dst + n) = float4{xs.x + m4.x * a.x, xs.y + m4.y * a.y, xs.z + m4.z * a.z, xs.w + m4.w * a.w};
    }
  }
};

struct EpiFFNin {
  const float* cw; const float* cb; bf16_t* a2;
  DI void operator()(const float* tile, int b, int s0, int col0) const {
    const int t = tidx(), c8 = (t & 7) * 8;
    const int ch = (col0 >> 7) * 64 + c8;
    float w0[8], w1[8], w2[8], bs[8];
#pragma unroll
    for (int e = 0; e < 8; ++e) { w0[e] = cw[ch + e]; w1[e] = cw[5632 + ch + e]; w2[e] = cw[2 * 5632 + ch + e]; bs[e] = cb[ch + e]; }
    for (int i = 1 + (t >> 3); i <= 126; i += 32) {
      const int s = s0 + i;
      if (s >= SB) break;
      const float* tr = tile + i * TS + c8;
      const bool hm = same_dom(s - 1, s), hp = same_dom(s + 1, s);
      float gm[8], g0[8], gp[8], u[8];
      *(float4*)(g0) = *(const float4*)(tr); *(float4*)(g0 + 4) = *(const float4*)(tr + 4);
      *(float4*)(u) = *(const float4*)(tr + 64); *(float4*)(u + 4) = *(const float4*)(tr + 68);
      *(float4*)(gm) = *(const float4*)(tr - TS); *(float4*)(gm + 4) = *(const float4*)(tr - TS + 4);
      *(float4*)(gp) = *(const float4*)(tr + TS); *(float4*)(gp + 4) = *(const float4*)(tr + TS + 4);
      float o[8];
#pragma unroll
      for (int e = 0; e < 8; ++e) {
        float a = bs[e] + w1[e] * g0[e];
        if (hm) a += w0[e] * gm[e];
        if (hp) a += w2[e] * gp[e];
        float inner = 0.7978845608028654f * (a + 0.044715f * a * a * a);
        o[e] = a * sigmoidf_(2.f * inner) * u[e];
      }
      *(uint4*)(a2 + ((size_t)b * SB + s) * LDA2 + ch) = uint4{pack2(o[0], o[1]), pack2(o[2], o[3]), pack2(o[4], o[5]), pack2(o[6], o[7])};
    }
  }
};

DI void conv_tile(const float* __restrict__ src, int Ksrc, int N, bf16_t* __restrict__ dst, int ldd, int kt, int nt, int perm,
                  const float* kscale, float* sm) {
  const int tid = tidx();
  const int k0 = kt * 64, n0 = nt * 64;
  {
    const int j = tid & 63;
    for (int i = tid >> 6; i < 64; i += 4) {
      float v = 0.f;
      if (k0 + i < Ksrc) {
        v = src[(size_t)(k0 + i) * N + n0 + j];
        if (kscale) v *= kscale[k0 + i];
      }
      sm[i * 65 + j] = v;
    }
  }
  __syncthreads();
  int r0 = n0;
  if (perm) r0 = (n0 < 5632) ? ((n0 >> 6) * 128) : ((((n0 - 5632) >> 6) * 128) + 64);
  {
    const int i2 = (tid & 31) * 2;
    for (int j = tid >> 5; j < 64; j += 8)
      *(unsigned*)(dst + (size_t)(r0 + j) * ldd + k0 + i2) = pack2(sm[i2 * 65 + j], sm[(i2 + 1) * 65 + j]);
  }
  __syncthreads();
}

DI void conv_tile_w(const float* __restrict__ src, int Ksrc, int N, bf16_t* __restrict__ dst, int ldd, int kt, int nt, int perm,
                    const float* kscale, float* sm) {
  const int tid = tidx();
  const int k0 = kt * 64, n0 = nt * 128;
  {
    const int j2 = (tid & 63) * 2;
    for (int i = tid >> 6; i < 64; i += 4) {
      float2 v = {0.f, 0.f};
      if (k0 + i < Ksrc) {
        v = *(const float2*)(src + (size_t)(k0 + i) * N + n0 + j2);
        if (kscale) { const float ks = kscale[k0 + i]; v.x *= ks; v.y *= ks; }
      }
      sm[i * 129 + j2] = v.x;
      sm[i * 129 + j2 + 1] = v.y;
    }
  }
  __syncthreads();
  {
    const int i2 = (tid & 31) * 2;
    for (int j = tid >> 5; j < 128; j += 8) {
      const int n = n0 + j;
      int r = n;
      if (perm) r = (n < 5632) ? ((n >> 6) * 128 + (n & 63)) : ((((n - 5632) >> 6) * 128) + 64 + ((n - 5632) & 63));
      *(unsigned*)(dst + (size_t)r * ldd + k0 + i2) = pack2(sm[i2 * 129 + j], sm[(i2 + 1) * 129 + j]);
    }
  }
  __syncthreads();
}

struct ConvJob { const float* src; bf16_t* dst; int K, N, ldd, perm; const float* ks; };
DI int job_tiles(const ConvJob& j) { return ((j.K + 63) >> 6) * ((j.N & 127) ? (j.N >> 6) : (j.N >> 7)); }
DI void run_job_tile(const ConvJob& j, int t, float* sm) {
  if (j.N & 127) {
    const int ntn = j.N >> 6;
    conv_tile(j.src, j.K, j.N, j.dst, j.ldd, t / ntn, t % ntn, j.perm, j.ks, sm);
  } else {
    const int ntn = j.N >> 7;
    conv_tile_w(j.src, j.K, j.N, j.dst, j.ldd, t / ntn, t % ntn, j.perm, j.ks, sm);
  }
}
DI bool get_wjob(const Params& P, int l, int j, ConvJob& o) {
  char* W = P.ws + OFF_W;
  switch (j) {
    case 0: o = ConvJob{P.in[7] + (size_t)l * D * INC, (bf16_t*)(W + W_IN), D, INC, LDW, 0, nullptr}; return true;
    case 1: case 2: case 3:
      o = ConvJob{P.in[27] + ((size_t)l * 3 + (j - 1)) * 1024 * D, (bf16_t*)(W + W_BR) + (size_t)(j - 1) * D * LDWB, 1024, D, LDWB, 0, nullptr}; return true;
    case 4: o = ConvJob{P.in[28] + (size_t)l * D * D, (bf16_t*)(W + W_OUT), D, D, LDW, 0, nullptr}; return true;
    case 5: o = ConvJob{P.in[25] + (size_t)l * 512 * 1536, (bf16_t*)(W + W_UQ), 512, 1536, LDUQ, 0, P.in[23] + l * 512}; return true;
    case 6: o = ConvJob{P.in[26] + (size_t)l * 512 * 2048, (bf16_t*)(W + W_UKV), 512, 2048, LDUQ, 0, P.in[24] + l * 512}; return true;
    case 7: case 8:
      o = ConvJob{P.in[10] + ((size_t)l * 2 + (j - 7)) * 96 * 1024, (bf16_t*)(W + W_W2) + (size_t)(j - 7) * 1024 * 128, 96, 1024, 128, 0, nullptr}; return true;
    case 9: case 10:
      o = ConvJob{P.in[12] + ((size_t)l * 2 + (j - 9)) * 96 * 1024, (bf16_t*)(W + W_A2) + (size_t)(j - 9) * 1024 * 128, 96, 1024, 128, 0, nullptr}; return true;
    case 11: o = ConvJob{P.in[13] + (size_t)l * 64 * 1024, (bf16_t*)(W + W_G2), 64, 1024, 64, 0, nullptr}; return true;
    case 12: if (l < 1) return false;
      o = ConvJob{P.in[20] + (size_t)(l - 1) * 1024 * 64, (bf16_t*)(W + W_V1), 1024, 64, 1024, 0, nullptr}; return true;
    case 13: if (l < 1) return false;
      o = ConvJob{P.in[21] + (size_t)(l - 1) * 64 * 1024, (bf16_t*)(W + W_V2), 64, 1024, 64, 0, nullptr}; return true;
  }
  return false;
}
DI void get_fjob(const Params& P, int l, int j, ConvJob& o) {
  char* Bg = P.ws + OFF_BIG;
  if (j == 0) o = ConvJob{P.in[30] + (size_t)l * D * 11264, (bf16_t*)(Bg + B_WFIN), D, 11264, LDW, 1, nullptr};
  else o = ConvJob{P.in[33] + (size_t)l * 5632 * D, (bf16_t*)(Bg + B_WFOUT), 5632, D, LDA2, 0, nullptr};
}
DI void run_conv_item(const Params& P, int lw, int lf, int it, float* sm) {
  ConvJob jb;
  if (lw >= 0) {
    for (int j = 0; j < 14; ++j) {
      if (!get_wjob(P, lw, j, jb)) continue;
      int nt = job_tiles(jb);
      if (it < nt) { run_job_tile(jb, it, sm); return; }
      it -= nt;
    }
  }
  if (lf >= 0) {
    for (int j = 0; j < 2; ++j) {
      get_fjob(P, lf, j, jb);
      int nt = job_tiles(jb);
      if (it < nt) { run_job_tile(jb, it, sm); return; }
      it -= nt;
    }
  }
}
DI int conv_total(int lw, int lf) {
  int n = 0;
  if (lw >= 0) n += 3072 + 3 * 256 + 512 + 96 + 128 + 4 * 16 + 8 + (lw >= 1 ? 16 + 8 : 0);
  if (lf >= 0) n += 32 * 88 + 88 * 16;
  return n;
}

DI void phase_init(const Params& P, char* smem) {
  float* cs = (float*)(P.ws + OFF_SMALL + S_COS);
  float* sn = (float*)(P.ws + OFF_SMALL + S_SIN);
  for (int idx = bidx() * 256 + tidx(); idx < SEQ * 32; idx += gdim() * 256) {
    int t = idx >> 5, d = idx & 31, f = d & 15;
    float inv = powf(10000.f, -(float)f / 16.f);
    float pos = (d < 16) ? (float)(t >> 6) : (float)(t & 63);
    float ang = pos * inv;
    cs[idx] = cosf(ang);
    sn[idx] = sinf(ang);
  }
  float* part = (float*)(P.ws + OFF_OA);
  const int nmod = 2 * 16 * 12;
  const int ntot = nmod + conv_total(0, -1);
  for (int it = bidx(); it < ntot; it += gdim()) {
    if (it < nmod) {
      int l = it / 192, r = it % 192, kc = r / 12, nc = r % 12;
      int n = nc * 1024 + tidx() * 4;
      float4 a0 = {0, 0, 0, 0}, a1 = {0, 0, 0, 0}, a2 = {0, 0, 0, 0};
      const float* w = P.in[4] + (size_t)l * D * INC + n;
      for (int k = kc * 128; k < kc * 128 + 128; ++k) {
        float c0 = P.in[1][k], c1 = P.in[1][D + k], c2 = P.in[3][k];
        c0 = c0 * sigmoidf_(c0); c1 = c1 * sigmoidf_(c1); c2 = c2 * sigmoidf_(c2);
        float4 wv = *(const float4*)(w + (size_t)k * INC);
        a0.x += c0 * wv.x; a0.y += c0 * wv.y; a0.z += c0 * wv.z; a0.w += c0 * wv.w;
        a1.x += c1 * wv.x; a1.y += c1 * wv.y; a1.z += c1 * wv.z; a1.w += c1 * wv.w;
        a2.x += c2 * wv.x; a2.y += c2 * wv.y; a2.z += c2 * wv.z; a2.w += c2 * wv.w;
      }
      float* pp = part + ((size_t)(l * 16 + kc) * 3) * INC + n;
      *(float4*)(pp) = a0;
      *(float4*)(pp + INC) = a1;
      *(float4*)(pp + 2 * INC) = a2;
    } else {
      run_conv_item(P, 0, -1, it - nmod, (float*)smem);
    }
  }
}

DI void phase_modred(const Params& P) {
  const float* part = (const float*)(P.ws + OFF_OA);
  float* mod = (float*)(P.ws + OFF_SMALL + S_MOD);
  for (int idx = bidx() * 256 + tidx(); idx < 2 * 3 * INC; idx += gdim() * 256) {
    int l = idx / (3 * INC), r = idx % (3 * INC), j = r / INC, n = r % INC;
    float a = P.in[5][l * INC + n];
    for (int kc = 0; kc < 16; ++kc) a += part[((size_t)(l * 16 + kc) * 3 + j) * INC + n];
    mod[idx] = a;
  }
}

DI void phase_norm(const Params& P, int l, int which) {
  const int lane = tidx() & 63, wid = tidx() >> 6;
  bf16_t* H = (bf16_t*)(P.ws + OFF_H);
  const float* g = (which == 1 ? P.in[6] : P.in[29]) + l * D;
  if (which == 1) {
    float* ssq = (float*)(P.ws + OFF_SMALL + S_SSQ);
    for (int idx = bidx() * 256 + tidx(); idx < T * 2; idx += gdim() * 256) ssq[idx] = 0.f;
  }
  for (int row = bidx() * 4 + wid; row < T; row += gdim() * 4) {
    const int b = row / SB, s = row - b * SB;
    const float* xr = (which == 1 && l == 0) ? xrow_in(P, row) : xrow(P, row);
    const float* sh = modvec(P, l, b, s, which == 1 ? 0 : 3);
    const float* sc = modvec(P, l, b, s, which == 1 ? 1 : 4);
    float4 v[8];
    float ss = 0.f;
#pragma unroll
    for (int i = 0; i < 8; ++i) {
      v[i] = *(const float4*)(xr + lane * 4 + i * 256);
      ss += v[i].x * v[i].x + v[i].y * v[i].y + v[i].z * v[i].z + v[i].w * v[i].w;
    }
    ss = wave_sum(ss);
    const float rs = rsqrtf(ss * (1.f / 2048.f) + 1e-6f);
#pragma unroll
    for (int i = 0; i < 8; ++i) {
      const int c = lane * 4 + i * 256;
      float4 gg = *(const float4*)(g + c), s4 = *(const float4*)(sh + c), c4 = *(const float4*)(sc + c);
      float o0 = v[i].x * rs * gg.x * (1.f + c4.x) + s4.x;
      float o1 = v[i].y * rs * gg.y * (1.f + c4.y) + s4.y;
      float o2 = v[i].z * rs * gg.z * (1.f + c4.z) + s4.z;
      float o3 = v[i].w * rs * gg.w * (1.f + c4.w) + s4.w;
      *(uint2*)(H + (size_t)row * LDH + c) = uint2{pack2(o0, o1), pack2(o2, o3)};
    }
  }
}

DI void phase_final(const Params& P) {
  const int lane = tidx() & 63, wid = tidx() >> 6;
  const float* g = P.in[34];
  for (int r = bidx() * 4 + wid; r < 2 * SEQ; r += gdim() * 4) {
    float* xr = P.out + (size_t)r * D;
    float4 v[8];
    float ss = 0.f;
#pragma unroll
    for (int i = 0; i < 8; ++i) {
      v[i] = *(const float4*)(xr + lane * 4 + i * 256);
      ss += v[i].x * v[i].x + v[i].y * v[i].y + v[i].z * v[i].z + v[i].w * v[i].w;
    }
    ss = wave_sum(ss);
    const float rs = rsqrtf(ss * (1.f / 2048.f) + 1e-6f);
#pragma unroll
    for (int i = 0; i < 8; ++i) {
      const int c = lane * 4 + i * 256;
      float4 gg = *(const float4*)(g + c);
      *(float4*)(xr + c) = float4{v[i].x * rs * gg.x, v[i].y * rs * gg.y, v[i].z * rs * gg.z, v[i].w * rs * gg.w};
    }
  }
}

template <class Epi>
DI void gemm_item_plain(const bf16_t* A, int lda, const bf16_t* Bt, int ldb, int K, int ntn, char* smem, const Epi& epi, int it) {
  int mt = it / ntn, nt = it - mt * ntn;
  int b = mt / 130, s0 = (mt - b * 130) * 128;
  gemm_tile(A, lda, Bt, ldb, K, b, s0, nt * 128, smem, epi);
}
template <class Epi>
DI void gemm_phase_plain(const bf16_t* A, int lda, const bf16_t* Bt, int ldb, int K, int ntn, char* smem, const Epi& epi) {
  const int total = 260 * ntn;
  for (int it = bidx(); it < total; it += gdim()) gemm_item_plain(A, lda, Bt, ldb, K, ntn, smem, epi, it);
}
template <class Epi>
DI void gemm_phase_overlap(const bf16_t* A, int lda, const bf16_t* Bt, int ldb, int K, int ntn, char* smem, const Epi& epi) {
  const int total = 266 * ntn;
  for (int it = bidx(); it < total; it += gdim()) {
    int mt = it / ntn, nt = it - mt * ntn;
    int b = mt / 133, s0 = (mt - b * 133) * 126 - 1;
    gemm_tile(A, lda, Bt, ldb, K, b, s0, nt * 128, smem, epi);
  }
}

DI void phase_lora(const Params& P, int l, char* smem) {
  char* W = P.ws + OFF_W; char* Bg = P.ws + OFF_BIG;
  const bf16_t* lora = (const bf16_t*)(Bg + B_LORA);
  if (bidx() == 0) {
    int* cnt = (int*)(P.ws + OFF_SMALL + S_CNT);
    for (int i = tidx(); i < 4096 + 64; i += 256) cnt[i] = 0;
  }
  const int per = 260 * 8;
  const int total = 5 * per + (l >= 1 ? 260 : 0);
  for (int it = bidx(); it < total; it += gdim()) {
    int j = it / per, r = it - j * per;
    if (j < 2) {
      EpiDecay e{P.in[9] + (size_t)(l * 2 + j) * 1024, (bf16_t*)(Bg + (j == 0 ? B_EF : B_EB))};
      gemm_item_plain(lora + j * 128, 576, (const bf16_t*)(W + W_W2) + (size_t)j * 1024 * 128, 128, 128, 8, smem, e, r);
    } else if (j < 4) {
      EpiSigBias e{P.in[11] + (size_t)(l * 2 + (j - 2)) * 1024, (bf16_t*)(Bg + (j == 2 ? B_AF : B_AB)), 1024};
      gemm_item_plain(lora + j * 128, 576, (const bf16_t*)(W + W_A2) + (size_t)(j - 2) * 1024 * 128, 128, 128, 8, smem, e, r);
    } else if (j == 4) {
      EpiStore e{(bf16_t*)(P.ws + OFF_OA), 1024, 1024};
      gemm_item_plain(lora + 512, 576, (const bf16_t*)(W + W_G2), 64, 64, 8, smem, e, r);
    } else {
      EpiStore e{(bf16_t*)(P.ws + OFF_SMALL + S_TV1), 64, 64};
      gemm_item_plain((const bf16_t*)(Bg + B_ZRKV) + 2048, 3072, (const bf16_t*)(W + W_V1), 1024, 1024, 1, smem, e, r);
    }
  }
}

DI void scan_load(u32x2 (&raw)[5], const bf16_t* R, const bf16_t* E, const bf16_t* Aa, int b, int dir, int i, int k4) {
  int s = dir == 0 ? i : (i < 256 ? 255 - i : 16895 - i);
  size_t row = (size_t)b * SB + s;
  raw[0] = gload8(R + row * 3072 + k4);
  raw[1] = gload8(R + row * 3072 + 1024 + k4);
  raw[2] = gload8(R + row * 3072 + 2048 + k4);
  raw[3] = gload8(E + row * 1024 + k4);
  raw[4] = gload8(Aa + row * 1024 + k4);
}
DI void scan_prep(u32x2 (&raw)[5], const float (&kkw)[4], const float (&kaw)[4], float* dst  ) {
  vm_wait5x2(raw[0], raw[1], raw[2], raw[3], raw[4]);
  float r[4] = {bflo(raw[0].x), bfhi(raw[0].x), bflo(raw[0].y), bfhi(raw[0].y)};
  float k[4] = {bflo(raw[1].x), bfhi(raw[1].x), bflo(raw[1].y), bfhi(raw[1].y)};
  float v[4] = {bflo(raw[2].x), bfhi(raw[2].x), bflo(raw[2].y), bfhi(raw[2].y)};
  float e[4] = {bflo(raw[3].x), bfhi(raw[3].x), bflo(raw[3].y), bfhi(raw[3].y)};
  float a[4] = {bflo(raw[4].x), bfhi(raw[4].x), bflo(raw[4].y), bfhi(raw[4].y)};
  float kr[4], ss = 0.f;
#pragma unroll
  for (int i = 0; i < 4; ++i) { kr[i] = mul_(k[i], kkw[i]); ss = (i < 3) ? fma_(kr[i], kr[i], ss) : fma_n_(kr[i], kr[i], ss); }
  ss = reduce16(ss);
  const float inv = __builtin_amdgcn_rcpf(fmaxf(__builtin_amdgcn_sqrtf(ss), 1e-12f));
  float w4[4], kd4[4], a4[4], b4[4];
#pragma unroll
  for (int i = 0; i < 4; ++i) {
    float kn = kr[i] * inv;
    w4[i] = __builtin_amdgcn_exp2f(mul_(e[i], -LOG2E));
    kd4[i] = mul_(k[i], fma_(add_(a[i], -1.f), kaw[i], 1.f));
    a4[i] = -kn;
    b4[i] = mul_(kn, a[i]);
  }
  *(float4*)(dst) = float4{r[0], r[1], r[2], r[3]};
  *(float4*)(dst + 64) = float4{w4[0], w4[1], w4[2], w4[3]};
  *(float4*)(dst + 128) = float4{kd4[0], kd4[1], kd4[2], kd4[3]};
  *(float4*)(dst + 192) = float4{a4[0], a4[1], a4[2], a4[3]};
  *(float4*)(dst + 256) = float4{b4[0], b4[1], b4[2], b4[3]};
  *(float4*)(dst + 320) = float4{v[0], v[1], v[2], v[3]};
}

DI void phase_scan(const Params& P, int l, char* smem) {
  char* Bg = P.ws + OFF_BIG;
  const int tid = tidx();
  const int st = tid >> 4, kl = tid & 15, k4 = kl * 4;
  float* buf = (float*)smem;
  for (int item = bidx(); item < 256; item += gdim()) {
    const int inst = item >> 2, vb = item & 3;
    const int b = inst >> 5, h = (inst >> 1) & 15, dir = inst & 1;
    const bf16_t* R = (const bf16_t*)(Bg + B_ZRKV) + h * 64;
    const bf16_t* E = (const bf16_t*)(Bg + (dir ? B_EB : B_EF)) + h * 64;
    const bf16_t* Aa = (const bf16_t*)(Bg + (dir ? B_AB : B_AF)) + h * 64;
    bf16_t* Y = (bf16_t*)(P.ws + (dir ? OFF_OC : OFF_OB)) + h * 64 + vb * 16;
    float kkw[4], kaw[4];
#pragma unroll
    for (int i = 0; i < 4; ++i) {
      kkw[i] = P.in[14][l * 1024 + h * 64 + k4 + i];
      kaw[i] = P.in[15][l * 1024 + h * 64 + k4 + i];
    }
    float S0 = 0.f, S1 = 0.f, S2 = 0.f, S3 = 0.f;
    u32x2 raw[5];
    scan_load(raw, R, E, Aa, b, dir, st, k4);
    scan_prep(raw, kkw, kaw, buf + st * 384 + k4);
    __syncthreads();
    const int nchunk = SB / 16;
    for (int c = 0; c < nchunk; ++c) {
      if (c + 1 < nchunk) scan_load(raw, R, E, Aa, b, dir, (c + 1) * 16 + st, k4);
      cfence();
      const float* cb = buf + (c & 1) * (16 * 384);
      float ykeep = 0.f;
#define SCAN_LOAD(SET, G)                                                          \
  _Pragma("unroll") for (int q_ = 0; q_ < 4; ++q_) {                                \
    const float* sb_ = cb + ((G) * 4 + q_) * 384;                                   \
    SET##r[q_] = *(const float4*)(sb_ + k4);                                        \
    SET##w[q_] = *(const float4*)(sb_ + 64 + k4);                                   \
    SET##k[q_] = *(const float4*)(sb_ + 128 + k4);                                  \
    SET##a[q_] = *(const float4*)(sb_ + 192 + k4);                                  \
    SET##b[q_] = *(const float4*)(sb_ + 256 + k4);                                  \
    SET##v[q_] = sb_[320 + vb * 16 + st];                                           \
  }
#define SCAN_STEPS(SET, G)                                                         \
  _Pragma("unroll") for (int q_ = 0; q_ < 4; ++q_) {                                \
    const float4 r4 = SET##r[q_], w4 = SET##w[q_], kd = SET##k[q_], a4 = SET##a[q_], b4 = SET##b[q_]; \
    const float vv = SET##v[q_];                                                    \
    float sa = fma_n_(S3, a4.w, fma_(S2, a4.z, fma_(S1, a4.y, mul_(S0, a4.x)))); \
    const float z0 = fma_(S0, w4.x, mul_(vv, kd.x)), z1 = fma_(S1, w4.y, mul_(vv, kd.y)); \
    const float z2 = fma_(S2, w4.z, mul_(vv, kd.z)), z3 = fma_(S3, w4.w, mul_(vv, kd.w)); \
    sa = reduce16(sa);                                                              \
    S0 = fma_(sa, b4.x, z0);                                                        \
    S1 = fma_(sa, b4.y, z1);                                                        \
    S2 = fma_(sa, b4.z, z2);                                                        \
    S3 = fma_(sa, b4.w, z3);                                                        \
    float y = fma_n_(S3, r4.w, fma_(S2, r4.z, fma_(S1, r4.y, mul_(S0, r4.x)))); \
    y = reduce16(y);                                                                \
    ykeep = sel_mask_(ykeep, y, 0x0001000100010001ull << ((G) * 4 + q_));            \
  }
      {
        float4 Ar[4], Aw[4], Ak[4], Aa[4], Ab[4], Br[4], Bw[4], Bk[4], Ba[4], Bb[4];
        float Av[4], Bv[4];
        SCAN_LOAD(A, 0);
        SCAN_LOAD(B, 1);
        SCAN_STEPS(A, 0);
        SCAN_LOAD(A, 2);
        SCAN_STEPS(B, 1);
        SCAN_LOAD(B, 3);
        SCAN_STEPS(A, 2);
        SCAN_STEPS(B, 3);
      }
#undef SCAN_LOAD
#undef SCAN_STEPS
      {
        int i = c * 16 + kl;
        int s = dir == 0 ? i : (i < 256 ? 255 - i : 16895 - i);
        Y[((size_t)b * SB + s) * 1024 + st] = f2bf(ykeep);
      }
      if (c + 1 < nchunk) scan_prep(raw, kkw, kaw, buf + ((c + 1) & 1) * (16 * 384) + st * 384 + k4);
      __syncthreads();
    }
  }
}

DI void phase_post(const Params& P, int l) {
  char* Bg = P.ws + OFF_BIG;
  const bf16_t* Z = (const bf16_t*)(Bg + B_ZRKV);
  const bf16_t* AF = (const bf16_t*)(Bg + B_AF);
  const bf16_t* AB = (const bf16_t*)(Bg + B_AB);
  const bf16_t* YF = (const bf16_t*)(P.ws + OFF_OB);
  const bf16_t* YB = (const bf16_t*)(P.ws + OFF_OC);
  bf16_t* OA = (bf16_t*)(P.ws + OFF_OA);
  const int kl = tidx() & 15;
  const int ngroups = T * 16;
  for (int gidx = bidx() * 16 + (tidx() >> 4); gidx < ngroups; gidx += gdim() * 16) {
    const int row = gidx >> 4, h = gidx & 15;
    const int c = h * 64 + kl * 4;
    uint2 uyf = *(const uint2*)(YF + (size_t)row * 1024 + c), uyb = *(const uint2*)(YB + (size_t)row * 1024 + c);
    float y[4] = {bflo(uyf.x) + bflo(uyb.x), bfhi(uyf.x) + bfhi(uyb.x), bflo(uyf.y) + bflo(uyb.y), bfhi(uyf.y) + bfhi(uyb.y)};
    float mean = reduce16(y[0] + y[1] + y[2] + y[3]) * (1.f / 64.f);
    float dd[4] = {y[0] - mean, y[1] - mean, y[2] - mean, y[3] - mean};
    float var = reduce16(dd[0] * dd[0] + dd[1] * dd[1] + dd[2] * dd[2] + dd[3] * dd[3]) * (1.f / 64.f);
    float rstd = rsqrtf(var + 64e-5f);
    uint2 ur = *(const uint2*)(Z + (size_t)row * 3072 + c), uk = *(const uint2*)(Z + (size_t)row * 3072 + 1024 + c),
          uv = *(const uint2*)(Z + (size_t)row * 3072 + 2048 + c);
    uint2 uaf = *(const uint2*)(AF + (size_t)row * 1024 + c), uab = *(const uint2*)(AB + (size_t)row * 1024 + c);
    uint2 ug = *(const uint2*)(OA + (size_t)row * 1024 + c);
    float r[4] = {bflo(ur.x), bfhi(ur.x), bflo(ur.y), bfhi(ur.y)};
    float k[4] = {bflo(uk.x), bfhi(uk.x), bflo(uk.y), bfhi(uk.y)};
    float v[4] = {bflo(uv.x), bfhi(uv.x), bflo(uv.y), bfhi(uv.y)};
    float af[4] = {bflo(uaf.x), bfhi(uaf.x), bflo(uaf.y), bfhi(uaf.y)};
    float ab[4] = {bflo(uab.x), bfhi(uab.x), bflo(uab.y), bfhi(uab.y)};
    float g[4] = {bflo(ug.x), bfhi(ug.x), bflo(ug.y), bfhi(ug.y)};
    float bon = 0.f;
#pragma unroll
    for (int i = 0; i < 4; ++i) {
      float ka = P.in[15][l * 1024 + c + i];
      float ksum = k[i] * (2.f + (af[i] + ab[i] - 2.f) * ka);
      bon += r[i] * ksum * P.in[16][l * 1024 + c + i];
    }
    bon = reduce16(bon);
    float o[4];
#pragma unroll
    for (int i = 0; i < 4; ++i) {
      float yn = dd[i] * rstd * P.in[17][l * 1024 + c + i] + P.in[18][l * 1024 + c + i];
      o[i] = (yn + bon * v[i]) * g[i];
    }
    *(uint2*)(OA + (size_t)row * 1024 + c) = uint2{pack2(o[0], o[1]), pack2(o[2], o[3])};
  }
}

DI int vswz(int d) { const int g = (d >> 2) & 7; return (g ^ ((g >> 2) * 3)) & 3; }
template <int DQK, int DV>
struct AttnMap {
  unsigned koff[DQK / 64], kl[DQK / 64];
  unsigned voff[DV / 64], vl0[DV / 64], vl1[DV / 64];
  DI void init(int ldk) {
    const int tid = tidx();
    constexpr int CPR = DQK / 8;
#pragma unroll
    for (int j = 0; j < DQK / 64; ++j) {
      int c = tid + 256 * j, row = c / CPR, kc = c - row * CPR;
      int pc = (kc & ~7) | ((kc & 7) ^ ((row >> 1) & 7));
      koff[j] = (unsigned)(row * ldk + kc * 8) * 2u;
      kl[j] = (unsigned)(row * (DQK * 2) + pc * 16);
    }
#pragma unroll
    for (int j = 0; j < DV / 64; ++j) {
      int c = tid + 256 * j, d = c >> 2, part = c & 3, f = vswz(d);
      voff[j] = (unsigned)(d * SB + part * 8) * 2u;
      vl0[j] = (unsigned)(d * 64 + (((2 * (part >> 1)) ^ f) << 4) + (part & 1) * 8);
      vl1[j] = (unsigned)(d * 64 + (((2 * (part >> 1) + 1) ^ f) << 4) + (part & 1) * 8);
    }
  }
};
template <int DQK, int DV>
DI void attn_load(u32x4 (&rk)[DQK / 64], u32x4 (&rv)[DV / 64], const AttnMap<DQK, DV>& mp, brsrc_t Kr, int ldk, brsrc_t Vr, int key0) {
  const unsigned ks = (unsigned)key0 * (unsigned)(ldk * 2), vs = (unsigned)key0 * 2u;
#pragma unroll
  for (int j = 0; j < DQK / 64; ++j) rk[j] = bload16(Kr, mp.koff[j], ks);
#pragma unroll
  for (int j = 0; j < DV / 64; ++j) rv[j] = bload16(Vr, mp.voff[j], vs);
}
template <int DQK, int DV>
DI void attn_store(u32x4 (&rk)[DQK / 64], u32x4 (&rv)[DV / 64], const AttnMap<DQK, DV>& mp, char* sK, char* sV) {
#pragma unroll
  for (int j = 0; j < DQK / 64; ++j) *(u32x4*)(sK + mp.kl[j]) = rk[j];
#pragma unroll
  for (int j = 0; j < DV / 64; ++j) {
    *(uint2*)(sV + mp.vl0[j]) = uint2{rv[j].x, rv[j].y};
    *(uint2*)(sV + mp.vl1[j]) = uint2{rv[j].z, rv[j].w};
  }
}

template <int DQK, int DV>
DI void attn_tile(const bf16_t* Q, int ldq, const bf16_t* Kb, int ldk, const bf16_t* Vt, bf16_t* O, int ldo, int b, int sq0,
                  int r0a, int r0b, int r1a, int r1b, float m_init, float l_init, char* smem) {
  const int tid = tidx(), lane = tid & 63, wid = tid >> 6;
  const int ql = lane & 31, hh = lane >> 5;
  constexpr int NS = DQK / 16, NB = DV / 32;
  constexpr int KB = 32 * DQK * 2, VB = DV * 64, BUF = KB + VB;
  const int qs = sq0 + wid * 32 + ql;
  bf16x8 qf[NS];
  {
    const bf16_t* qp = Q + (size_t)(b * SB + qs) * ldq + 8 * hh;
#pragma unroll
    for (int s = 0; s < NS; ++s) qf[s] = *(const bf16x8*)(qp + 16 * s);
  }
  f32x16 acc[NB];
#pragma unroll
  for (int i = 0; i < NB; ++i)
#pragma unroll
    for (int r = 0; r < 16; ++r) acc[i][r] = 0.f;
  float m = m_init, lsum = l_init;
  const int n0 = (r0b - r0a) >> 5, n1 = (r1b > r1a) ? ((r1b - r1a) >> 5) : 0;
  const int nt = n0 + n1;
  const brsrc_t Kbase = make_rsrc(Kb + (size_t)b * SB * ldk);
  const brsrc_t Vbase = make_rsrc(Vt);
  AttnMap<DQK, DV> mp;
  mp.init(ldk);
  u32x4 rk[DQK / 64], rv[DV / 64];
  attn_load<DQK, DV>(rk, rv, mp, Kbase, ldk, Vbase, r0a);
  attn_store<DQK, DV>(rk, rv, mp, smem, smem + KB);
  __syncthreads();
  for (int it = 0; it < nt; ++it) {
    const int key0 = it < n0 ? r0a + 32 * it : r1a + 32 * (it - n0);
    const bool masked = it >= n0;
    {
      const int itn = (it + 1 < nt) ? it + 1 : it;
      const int nk0 = itn < n0 ? r0a + 32 * itn : r1a + 32 * (itn - n0);
      attn_load<DQK, DV>(rk, rv, mp, Kbase, ldk, Vbase, nk0);
    }
    cfence();
    const char* sK = smem + (it & 1) * BUF;
    const char* sV = sK + KB;
    f32x16 S;
#pragma unroll
    for (int r = 0; r < 16; ++r) S[r] = 0.f;
    {
      const char* kr = sK + ql * (DQK * 2);
      const int f = (ql >> 1) & 7;
#pragma unroll
      for (int s = 0; s < NS; ++s) {
        const int c = 2 * s + hh;
        const int pc = (c & ~7) | ((c & 7) ^ f);
        bf16x8 kf = *(const bf16x8*)(kr + pc * 16);
        S = MFMA32(kf, qf[s], S);
      }
    }
    if (masked) {
#pragma unroll
      for (int r = 0; r < 16; ++r) {
        int ks = key0 + (r & 3) + 8 * (r >> 2) + 4 * hh;
        int df = ks - qs;
        if (df > 128 || df < -128) S[r] = -1e30f;
      }
    }
    float mx = S[0];
#pragma unroll
    for (int r = 1; r < 16; ++r) mx = fmaxf(mx, S[r]);
    mx = xhalf_max(mx);
    const float mn = fmaxf(m, mx);
    const float alpha = __builtin_amdgcn_exp2f(m - mn);
    m = mn;
    float p[16], rsum = 0.f;
#pragma unroll
    for (int r = 0; r < 16; ++r) { p[r] = __builtin_amdgcn_exp2f(S[r] - mn); rsum += p[r]; }
    rsum = xhalf_sum(rsum);
    lsum = lsum * alpha + rsum;
    if (__any(alpha != 1.f)) {
#pragma unroll
      for (int i = 0; i < NB; ++i)
#pragma unroll
        for (int r = 0; r < 16; ++r) acc[i][r] *= alpha;
    }
    bf16x8 pf[2];
#pragma unroll
    for (int s2 = 0; s2 < 2; ++s2) {
      unsigned w0 = pack2(p[8 * s2 + 0], p[8 * s2 + 1]), w1 = pack2(p[8 * s2 + 2], p[8 * s2 + 3]);
      unsigned w2 = pack2(p[8 * s2 + 4], p[8 * s2 + 5]), w3 = pack2(p[8 * s2 + 6], p[8 * s2 + 7]);
      uint4 u = {w0, w1, w2, w3};
      pf[s2] = __builtin_bit_cast(bf16x8, u);
    }
#pragma unroll
    for (int i = 0; i < NB; ++i) {
      const int d = i * 32 + ql, f = vswz(d);
      const char* vr = sV + d * 64;
#pragma unroll
      for (int s2 = 0; s2 < 2; ++s2) {
        bf16x8 vf = *(const bf16x8*)(vr + (((2 * s2 + hh) ^ f) << 4));
        acc[i] = MFMA32(vf, pf[s2], acc[i]);
      }
    }
    {
      char* dK = smem + ((it + 1) & 1) * BUF;
      attn_store<DQK, DV>(rk, rv, mp, dK, dK + KB);
    }
    __syncthreads();
  }
  const float inv = 1.f / lsum;
  bf16_t* op = O + (size_t)(b * SB + qs) * ldo;
#pragma unroll
  for (int i = 0; i < NB; ++i)
#pragma unroll
    for (int g = 0; g < 4; ++g) {
      uint2 u = {pack2(acc[i][4 * g] * inv, acc[i][4 * g + 1] * inv), pack2(acc[i][4 * g + 2] * inv, acc[i][4 * g + 3] * inv)};
      *(uint2*)(op + i * 32 + 8 * g + 4 * hh) = u;
    }
}

DI void phase_attn(const Params& P, int l, char* smem) {
  char* Bg = P.ws + OFF_BIG;
  const int nmla_l = 2048, nmla_c = 32, nwa = 2 * 16 * 130;
  const int total = nmla_l + nmla_c + nwa;
  for (int it = bidx(); it < total; it += gdim()) {
    if (l == 1) {
      if (it >= nmla_l && it < nmla_l + nmla_c) continue;
      if (it >= nmla_l + nmla_c && ((it - nmla_l - nmla_c) % 130) < 2) continue;
    }
    if (it < nmla_l + nmla_c) {
      int b, h, sq0, kend;
      if (it < nmla_l) {
        const int j = (it & 7) * (nmla_l >> 3) + (it >> 3);
        int bh = j >> 7, qt = j & 127; b = bh >> 3; h = bh & 7; sq0 = CTXL + 128 * qt; kend = SB;
      }
      else { int i2 = it - nmla_l; int bh = i2 >> 1, qt = i2 & 1; b = bh >> 3; h = bh & 7; sq0 = 128 * qt; kend = CTXL; }
      attn_tile<192, 128>((const bf16_t*)(Bg + B_QMLA) + h * 192, LDKQ, (const bf16_t*)(Bg + B_KMLA) + h * 192, LDKQ,
                          (const bf16_t*)(Bg + B_VTMLA) + ((size_t)b * 1024 + h * 128) * SB, (bf16_t*)(P.ws + OFF_OC) + h * 128, 1024,
                          b, sq0, 0, kend, 0, 0, -1e30f, 0.f, smem);
    } else {
      int i2 = it - nmla_l - nmla_c;
      int bh = i2 / 130, qt = i2 - bh * 130;
      int b = bh >> 4, h = bh & 15, kvh = h >> 2;
      int sq0 = 128 * qt;
      int r1a = 0, r1b = 0;
      if (qt >= 2) {
        r1a = sq0 - 128; if (r1a < CTXL) r1a = CTXL;
        r1b = sq0 + 256; if (r1b > SB) r1b = SB;
      }
      float sink = P.in[22][l * 16 + h] * LOG2E;
      attn_tile<64, 64>((const bf16_t*)(Bg + B_QWA) + h * 64, 1024, (const bf16_t*)(Bg + B_KWA) + kvh * 64, 256,
                        (const bf16_t*)(Bg + B_VTWA) + ((size_t)b * 256 + kvh * 64) * SB, (bf16_t*)(P.ws + OFF_OB) + h * 64, 1024,
                        b, sq0, 0, CTXL, r1a, r1b, sink, 1.f, smem);
    }
  }
}

DI void phase_inproj_att(const Params& P, int l, char* smem) {
  char* W = P.ws + OFF_W; char* Bg = P.ws + OFF_BIG;
  const bf16_t* H = (const bf16_t*)(P.ws + OFF_H);
  const float* cs = (const float*)(P.ws + OFF_SMALL + S_COS);
  const float* sn = (const float*)(P.ws + OFF_SMALL + S_SIN);
  const int nwa = 130 * 12, nml = 130 * 9;
  for (int it = bidx(); it < nwa + nml; it += gdim()) {
    if (it < nwa) {
      EpiWA e{(bf16_t*)(Bg + B_QWA), (bf16_t*)(Bg + B_KWA), (bf16_t*)(Bg + B_VTWA), cs, sn};
      gemm256_item_plain(H, LDH, (const bf16_t*)(W + W_IN) + (size_t)3520 * LDW, LDW, D, 12, smem, e, it);
    } else {
      EpiMLAin e{(bf16_t*)(Bg + B_ZMLA), (float*)(P.ws + OFF_SMALL + S_SSQ)};
      gemm256_item_plain(H, LDH, (const bf16_t*)(W + W_IN) + (size_t)5056 * LDW, LDW, D, 9, smem, e, it - nwa);
    }
  }
}

DI void phase_uproj(const Params& P, int l, char* smem) {
  char* W = P.ws + OFF_W; char* Bg = P.ws + OFF_BIG;
  const bf16_t* Z = (const bf16_t*)(Bg + B_ZMLA);
  const float* cs = (const float*)(P.ws + OFF_SMALL + S_COS);
  const float* sn = (const float*)(P.ws + OFF_SMALL + S_SIN);
  const float* ssq = (const float*)(P.ws + OFF_SMALL + S_SSQ);
  bf16_t* Kd = (bf16_t*)(Bg + B_KMLA);
  for (int idx = bidx() * 256 + tidx(); idx < T * 32; idx += gdim() * 256) {
    int row = idx >> 5, d = idx & 31;
    int b = row / SB, s = row - b * SB;
    float a = bf2f(Z[(size_t)row * 1088 + 1024 + d]), bb = bf2f(Z[(size_t)row * 1088 + 1024 + d + 32]);
    if (s >= CTXL) rope_pair(a, bb, cs, sn, s - CTXL, d);
    bf16_t ua = f2bf(a), ub = f2bf(bb);
#pragma unroll
    for (int h = 0; h < 8; ++h) {
      Kd[(size_t)row * LDKQ + h * 192 + 128 + d] = ua;
      Kd[(size_t)row * LDKQ + h * 192 + 160 + d] = ub;
    }
  }
  const int nq = 130 * 12, nkv = 130 * 16;
  for (int it = bidx(); it < nq + nkv; it += gdim()) {
    if (it < nq) {
      EpiUQ e{(bf16_t*)(Bg + B_QMLA), ssq, cs, sn};
      gemm256_item_plain(Z, 1088, (const bf16_t*)(W + W_UQ), LDUQ, 512, 12, smem, e, it);
    } else {
      EpiUKV e{Kd, (bf16_t*)(Bg + B_VTMLA), ssq};
      gemm256_item_plain(Z + 512, 1088, (const bf16_t*)(W + W_UKV), LDUQ, 512, 16, smem, e, it - nq);
    }
  }
}

DI void phase_merge(const Params& P, char* smem, bool skip_ctx) {
  char* W = P.ws + OFF_W;
  const bf16_t* G = (const bf16_t*)(P.ws + OFF_BIG + B_G);
  bf16_t* Y = (bf16_t*)(P.ws + OFF_H);
  const int tid = tidx(), lane = tid & 63, wid = tid >> 6;
  const int wr = wid >> 1, wc = wid & 1, fr = lane & 15, fq = lane >> 4;
  const int total = 260 * 16;
  for (int it = bidx(); it < total; it += gdim()) {
    int mt = it >> 4, nt = it & 15;
    int b = mt / 130, s0 = (mt - b * 130) * 128, col0 = nt * 128;
    if (skip_ctx && s0 < CTXL) continue;
    f32x4 yacc[4][4];
    zero_acc(yacc);
#pragma unroll 1
    for (int i = 0; i < 3; ++i) {
      f32x4 acc[4][4];
      zero_acc(acc);
      const bf16_t* Oi = (const bf16_t*)(P.ws + (i == 0 ? OFF_OA : (i == 1 ? OFF_OB : OFF_OC)));
      gemm_kloop1(acc, Oi, 1024, (const bf16_t*)(W + W_BR) + (size_t)i * D * LDWB, LDWB, 1024, b, s0, col0, smem);
#pragma unroll
      for (int m = 0; m < 4; ++m)
#pragma unroll
        for (int n = 0; n < 4; ++n)
#pragma unroll
          for (int j = 0; j < 4; ++j) {
            size_t row = (size_t)b * SB + s0 + wr * 64 + m * 16 + fq * 4 + j;
            float gv = bf2f(G[row * 6144 + i * 2048 + col0 + wc * 64 + n * 16 + fr]);
            yacc[m][n][j] += gv * acc[m][n][j];
          }
    }
    float* tile = (float*)smem;
    acc_to_tile(yacc, tile);
    __syncthreads();
    EpiStore e{Y, LDH, D};
    e(tile, b, s0, col0);
    __syncthreads();
  }
}

constexpr int NPHASE = 33;
#ifndef PH_MASK
#define PH_MASK 0xFFFFFFFFu
#endif
#define PH_ON(n) ((PH_MASK >> (n)) & 1u)
DI bool phase_empty(int ph) { return ph == 2 + 3; }

DI void run_phase(const Params& P, int ph, char* smem) {
  if (ph == 0) { if (PH_ON(15)) phase_init(P, smem); return; }
  if (ph == 1) { if (PH_ON(16)) phase_modred(P); return; }
  if (ph == 32) { if (PH_ON(17)) phase_final(P); return; }
  const int l = (ph - 2) / 15, q = (ph - 2) % 15;
  char* W = P.ws + OFF_W; char* Bg = P.ws + OFF_BIG;
  const bf16_t* H = (const bf16_t*)(P.ws + OFF_H);
  switch (q) {
    case 0: if (PH_ON(0)) phase_norm(P, l, 1); break;
    case 1: if (PH_ON(1)) {
      EpiRW e{P.in[8] + (size_t)l * 3520, (bf16_t*)(Bg + B_ZRKV), (bf16_t*)(Bg + B_LORA), l == 0 ? (bf16_t*)(P.ws + OFF_VF) : nullptr};
      gemm256_phase_overlap(H, LDH, (const bf16_t*)(W + W_IN), LDW, D, 28, smem, e);
    } break;
    case 2: if (PH_ON(2)) phase_lora(P, l, smem); break;
    case 3: if (PH_ON(3)) {
      if (l >= 1) {
        EpiVres e{P.in[19] + (size_t)(l - 1) * 1024, (bf16_t*)(Bg + B_ZRKV), (const bf16_t*)(P.ws + OFF_VF)};
        gemm_phase_plain((const bf16_t*)(P.ws + OFF_SMALL + S_TV1), 64, (const bf16_t*)(W + W_V2), 64, 64, 8, smem, e);
      }
    } break;
    case 4: if (PH_ON(4)) phase_scan(P, l, smem); break;
    case 5: if (PH_ON(5)) phase_post(P, l); break;
    case 6: if (PH_ON(6)) phase_inproj_att(P, l, smem); break;
    case 7: if (PH_ON(7)) phase_uproj(P, l, smem); break;
    case 8: if (PH_ON(8)) phase_attn(P, l, smem); break;
    case 9: if (PH_ON(9)) {
      EpiSigBias e{nullptr, (bf16_t*)(Bg + B_G), 6144};
      gemm256_phase_plain(H, LDH, (const bf16_t*)(W + W_IN) + (size_t)6144 * LDW, LDW, D, 48, smem, e, l == 1);
    } break;
    case 10: if (PH_ON(10)) phase_merge(P, smem, l == 1); break;
    case 11: if (PH_ON(11)) {
      EpiResid e{&P, l, 2, l == 0};
      gemm256_phase_plain(H, LDH, (const bf16_t*)(W + W_OUT), LDW, D, 16, smem, e, l == 1);
    } break;
    case 12: if (PH_ON(12)) {
      phase_norm(P, l, 2);
      const int lw = (l + 1 < 2) ? l + 1 : -1;
      const int tot = conv_total(lw, l);
      for (int it = bidx(); it < tot; it += gdim()) run_conv_item(P, lw, l, it, (float*)smem);
    } break;
    case 13: if (PH_ON(13)) {
      EpiFFNin e{P.in[31] + (size_t)l * 3 * 5632, P.in[32] + (size_t)l * 5632, (bf16_t*)(Bg + B_A2)};
      gemm256_phase_overlap(H, LDH, (const bf16_t*)(Bg + B_WFIN), LDW, D, 88, smem, e);
    } break;
    case 14: if (PH_ON(14)) {
      EpiResid e{&P, l, 5, false};
      gemm256_phase_plain((const bf16_t*)(Bg + B_A2), LDA2, (const bf16_t*)(Bg + B_WFOUT), LDA2, 5632, 16, smem, e, l == 1);
    } break;
  }
}

__global__ void __launch_bounds__(256, 2) mega(Params P) {
  __shared__ __attribute__((aligned(16))) char smem[69632];
  const int p0 = P.p0, p1 = P.p1;
  for (int ph = p0; ph < p1; ++ph) {
    if (phase_empty(ph)) continue;
    const __attribute__((address_space(4))) char* kp = (const __attribute__((address_space(4))) char*)__builtin_amdgcn_kernarg_segment_ptr();
    asm volatile("" : "+s"(kp));
    const Params& Pr = *(const Params*)(kp);
    int nrep = 1;
#ifdef REP_MASK
    if (ph >= 2 && ph < 32 && ((REP_MASK >> ((ph - 2) % 15)) & 1)) nrep = 2;
#endif
#pragma unroll 1
    for (int rep = 0; rep < nrep; ++rep) run_phase(Pr, ph, smem);
    if (ph + 1 < p1) cg::this_grid().sync();
  }
}

extern "C" void kernel_launch(void* const* d_in, const int* in_sizes, int n_in, void* d_out, int out_size, void* d_ws,
                              size_t ws_size, hipStream_t stream) {
  static int grid_blocks = 0;
  if (!grid_blocks) {
    int dev = 0, cus = 0, per_cu = 0;
    hipGetDevice(&dev);
    hipDeviceGetAttribute(&cus, hipDeviceAttributeMultiprocessorCount, dev);
    hipOccupancyMaxActiveBlocksPerMultiprocessor(&per_cu, mega, 256, 0);
    if (per_cu < 1) per_cu = 1;
    grid_blocks = cus * per_cu;
  }
  Params p;
  memset(&p, 0, sizeof(p));
  for (int i = 0; i < 35; ++i) p.in[i] = (const float*)d_in[i];
  p.out = (float*)d_out;
  p.ws = (char*)d_ws;
#if ONE_LAUNCH
  p.p0 = 0; p.p1 = NPHASE;
  void* args[] = {&p};
  hipError_t e = hipLaunchCooperativeKernel((void*)mega, dim3(grid_blocks), dim3(256), args, 0, stream);
  if (e != hipSuccess) fprintf(stderr, "cooperative launch failed: %s (grid %d)\n", hipGetErrorString(e), grid_blocks);
#else
  for (int ph = 0; ph < NPHASE; ++ph) {
    if (ph == 2 + 3) continue;
    p.p0 = ph; p.p1 = ph + 1;
    hipLaunchKernelGGL(mega, dim3(grid_blocks), dim3(256), 0, stream, p);
  }
#endif
}
```
